# Optimizing an MI355X kernel written in HIP

```python
import math
import jax, jax.numpy as jnp
from jax import lax
import numpy as np

D_MODEL = 1024
BATCH = 8
SEQ = 4096
DEPTH = 2

CONV_K = 4
CHUNK = 64
NORM_EPS = 1e-6
DT_MIN = 1e-3
DT_MAX = 1e-1
S5_GROUP = 16
S5_STATE = 64
S5_WIDTH = 3 * D_MODEL // 8
S5_GROUPS = S5_WIDTH // S5_GROUP
GDN_HEADS = 4
GDN_DK = 128
GDN_DV = 128
GDN_QK = GDN_HEADS * GDN_DK
GDN_WIDTH = GDN_HEADS * GDN_DV
SSD_HEAD_DIM = 64
SSD_WIDTH = D_MODEL // 2
SSD_HEADS = SSD_WIDTH // SSD_HEAD_DIM
SSD_GROUPS = 2
SSD_HPG = SSD_HEADS // SSD_GROUPS
SSD_STATE = 64
SSD_BC = SSD_GROUPS * SSD_STATE
LRU_WIDTH = D_MODEL // 2
LRU_BLOCK = 64
LRU_BLOCKS = LRU_WIDTH // LRU_BLOCK
LRU_C = 8.0
N_BRANCH = 4
BRANCH_WIDTHS = (S5_WIDTH, GDN_WIDTH, SSD_WIDTH, LRU_WIDTH)
MIX_WIDTH = sum(BRANCH_WIDTHS)
CONV_SILU_WIDTHS = (GDN_QK, GDN_QK, GDN_WIDTH, SSD_WIDTH, SSD_BC, SSD_BC)
CONV_SILU_CH = sum(CONV_SILU_WIDTHS)
CONV_CH = CONV_SILU_CH + LRU_WIDTH
REST_WIDTHS = (S5_WIDTH, GDN_HEADS, GDN_HEADS, GDN_WIDTH, SSD_WIDTH, SSD_HEADS, LRU_WIDTH, N_BRANCH * D_MODEL)
IN_COLS = CONV_CH + sum(REST_WIDTHS)
FFN_HIDDEN = -(-8 * D_MODEL // (3 * 256)) * 256

kernel_name = "adaln_hybrid_s5_gdn_ssd_rglru_trunk"

F32 = jnp.float32


def _rms(x):
    x32 = x.astype(F32)
    return x32 * lax.rsqrt(jnp.mean(x32 * x32, axis=-1, keepdims=True) + NORM_EPS)


def _split(t, widths, axis=-1):
    idx, acc = [], 0
    for w in widths[:-1]:
        acc += w
        idx.append(acc)
    return jnp.split(t, idx, axis=axis)


def _causal_conv(x, w, b):
    k_taps, s = w.shape[0], x.shape[1]
    xp = jnp.pad(x, ((0, 0), (k_taps - 1, 0), (0, 0)))
    y = b + xp[:, 0:s] * w[0]
    for k in range(1, k_taps):
        y = y + xp[:, k:k + s] * w[k]
    return y


def _causal_masks(n):
    pos = jnp.arange(n)
    return pos[:, None] >= pos[None, :], pos[:, None] > pos[None, :]


def _segment_decay(cs, incl):
    diff = cs[..., :, None] - cs[..., None, :]
    return jnp.exp(jnp.where(incl, diff, -jnp.inf))


def _linear_combine(left, right):
    a_l, b_l = left
    a_r, b_r = right
    return a_r * a_l, a_r * b_l + b_r


def _s5_branch(u, lam_re, lam_im, log_dt, b_re, b_im, c_re, c_im, d, glu_w, glu_b):
    bsz, s, _ = u.shape
    ug = u.astype(F32).reshape(bsz, s, S5_GROUPS, S5_GROUP)
    lam = lax.complex(lam_re.astype(F32), lam_im.astype(F32))
    dt = jnp.exp(log_dt.astype(F32))[:, None]
    lam_bar = jnp.exp(lam * dt)
    b_mat = lax.complex(b_re.astype(F32), b_im.astype(F32))
    b_bar = ((lam_bar - 1.0) / lam)[..., None] * b_mat
    bu = jnp.einsum('bsgh,gph->bsgp', ug.astype(jnp.complex64), b_bar)
    a = jnp.broadcast_to(lam_bar, (1, s) + lam_bar.shape)
    _, states = lax.associative_scan(_linear_combine, (a, bu), axis=1)
    c_mat = lax.complex(c_re.astype(F32), c_im.astype(F32))
    y = jnp.real(jnp.einsum('bsgp,ghp->bsgh', states, c_mat)) + d.astype(F32).reshape(S5_GROUPS, S5_GROUP) * ug
    y = jax.nn.gelu(y.reshape(bsz, s, S5_WIDTH))
    return y * jax.nn.sigmoid(y @ glu_w.astype(F32) + glu_b.astype(F32))


def _chunked_gated_delta(q, k, v, g, beta):
    bsz, s, h, dk = q.shape
    dv = v.shape[-1]
    nc = s // CHUNK

    def blocks(t):
        return jnp.moveaxis(t.reshape((bsz, nc, CHUNK, h) + t.shape[3:]), 3, 2)

    q, k, v, g, beta = blocks(q), blocks(k), blocks(v), blocks(g), blocks(beta)
    g = jnp.cumsum(g, axis=-1)
    incl, strict = _causal_masks(CHUNK)
    decay = _segment_decay(g, incl)
    kb = k * beta[..., None]
    a_strict = jnp.where(strict, jnp.einsum('bnhcd,bnhsd->bnhcs', kb, k) * decay, 0.0)
    t_mat = a_strict + jnp.eye(CHUNK, dtype=F32)
    rhs = jnp.concatenate([kb * jnp.exp(g)[..., None], v * beta[..., None]], axis=-1)
    sol = lax.linalg.triangular_solve(t_mat, rhs, left_side=True, lower=True, unit_diagonal=True)
    w, u = sol[..., :dk], sol[..., dk:]
    attn = jnp.einsum('bnhcd,bnhsd->bnhcs', q, k) * decay
    g_last = g[..., -1]
    q_dec = q * jnp.exp(g)[..., None]
    k_dec = k * jnp.exp(g_last[..., None] - g)[..., None]

    def step(state, inp):
        w_c, u_c, q_c, k_c, attn_c, gl_c = inp
        v_new = u_c - jnp.einsum('bhcd,bhde->bhce', w_c, state)
        o_c = jnp.einsum('bhcd,bhde->bhce', q_c, state) + jnp.einsum('bhcs,bhse->bhce', attn_c, v_new)
        state = state * jnp.exp(gl_c)[..., None, None] + jnp.einsum('bhcd,bhce->bhde', k_c, v_new)
        return state, o_c

    xs = tuple(jnp.moveaxis(t, 1, 0) for t in (w, u, q_dec, k_dec, attn, g_last))
    _, o = lax.scan(step, jnp.zeros((bsz, h, dk, dv), F32), xs)
    return jnp.transpose(o, (1, 0, 3, 2, 4)).reshape(bsz, s, h, dv)


def _gdn_branch(q, k, v, b_raw, a_raw, z, a_log, dt_bias, norm_w):
    bsz, s, _ = q.shape
    q = q.astype(F32).reshape(bsz, s, GDN_HEADS, GDN_DK)
    k = k.astype(F32).reshape(bsz, s, GDN_HEADS, GDN_DK)
    v = v.astype(F32).reshape(bsz, s, GDN_HEADS, GDN_DV)
    q = q * lax.rsqrt(jnp.sum(q * q, axis=-1, keepdims=True) + NORM_EPS) * (GDN_DK ** -0.5)
    k = k * lax.rsqrt(jnp.sum(k * k, axis=-1, keepdims=True) + NORM_EPS)
    beta = jax.nn.sigmoid(b_raw.astype(F32))
    g = -jnp.exp(a_log.astype(F32)) * jax.nn.softplus(a_raw.astype(F32) + dt_bias.astype(F32))
    o = _chunked_gated_delta(q, k, v, g, beta)
    o = _rms(o) * norm_w.astype(F32) * jax.nn.silu(z.astype(F32).reshape(bsz, s, GDN_HEADS, GDN_DV))
    return o.reshape(bsz, s, GDN_WIDTH)


def _chunked_ssd(xdt, la, bm, cm):
    bsz, s = xdt.shape[:2]
    nc = s // CHUNK
    xdt = xdt.reshape(bsz, nc, CHUNK, SSD_GROUPS, SSD_HPG, SSD_HEAD_DIM)
    bm = bm.reshape(bsz, nc, CHUNK, SSD_GROUPS, SSD_STATE)
    cm = cm.reshape(bsz, nc, CHUNK, SSD_GROUPS, SSD_STATE)
    cs = jnp.cumsum(jnp.moveaxis(la.reshape(bsz, nc, CHUNK, SSD_GROUPS, SSD_HPG), 2, -1), axis=-1)
    incl, _ = _causal_masks(CHUNK)
    decay = _segment_decay(cs, incl)
    cb = jnp.einsum('bzlgn,bzmgn->bzglm', cm, bm)
    y_diag = jnp.einsum('bzglm,bzgjlm,bzmgjp->bzlgjp', cb, decay, xdt)
    to_end = jnp.exp(cs[..., -1:] - cs)
    chunk_states = jnp.einsum('bzmgn,bzgjm,bzmgjp->bzgjpn', bm, to_end, xdt)
    chunk_decay = jnp.exp(cs[..., -1])

    def step(state, inp):
        st_c, dec_c = inp
        return state * dec_c[..., None, None] + st_c, state

    state0 = jnp.zeros((bsz, SSD_GROUPS, SSD_HPG, SSD_HEAD_DIM, SSD_STATE), F32)
    _, prev = lax.scan(step, state0, (jnp.moveaxis(chunk_states, 1, 0), jnp.moveaxis(chunk_decay, 1, 0)))
    prev = jnp.moveaxis(prev, 0, 1)
    y_off = jnp.einsum('bzlgn,bzgjpn,bzgjl->bzlgjp', cm, prev, jnp.exp(cs))
    return (y_diag + y_off).reshape(bsz, s, SSD_GROUPS, SSD_HPG, SSD_HEAD_DIM)


def _ssd_branch(xs, bs, cs, z, dt_raw, a_log, dt_bias, d, norm_w):
    bsz, s, _ = xs.shape
    x = xs.astype(F32).reshape(bsz, s, SSD_GROUPS, SSD_HPG, SSD_HEAD_DIM)
    bm = bs.astype(F32).reshape(bsz, s, SSD_GROUPS, SSD_STATE)
    cm = cs.astype(F32).reshape(bsz, s, SSD_GROUPS, SSD_STATE)
    dt = jax.nn.softplus(dt_raw.astype(F32) + dt_bias.astype(F32)).reshape(bsz, s, SSD_GROUPS, SSD_HPG)
    a = -jnp.exp(a_log.astype(F32)).reshape(SSD_GROUPS, SSD_HPG)
    y = _chunked_ssd(x * dt[..., None], dt * a, bm, cm)
    y = y + d.astype(F32).reshape(SSD_GROUPS, SSD_HPG)[..., None] * x
    y = y.reshape(bsz, s, SSD_WIDTH) * jax.nn.silu(z.astype(F32))
    return _rms(y) * norm_w.astype(F32)


def _rglru_branch(x, gate, lam, wr, br, wi, bi):
    bsz, s, _ = x.shape
    x = x.astype(F32)
    xb = x.reshape(bsz, s, LRU_BLOCKS, LRU_BLOCK)
    r = jax.nn.sigmoid(jnp.einsum('bsnd,nde->bsne', xb, wr.astype(F32)).reshape(bsz, s, LRU_WIDTH) + br.astype(F32))
    i = jax.nn.sigmoid(jnp.einsum('bsnd,nde->bsne', xb, wi.astype(F32)).reshape(bsz, s, LRU_WIDTH) + bi.astype(F32))
    log_a = -LRU_C * r * jax.nn.softplus(-lam.astype(F32))
    a = jnp.exp(log_a)
    mult = jnp.sqrt(-jnp.expm1(2.0 * log_a))
    mult = jnp.where((jnp.arange(s) == 0)[None, :, None], 1.0, mult)
    _, h = lax.associative_scan(_linear_combine, (a, mult * i * x), axis=1)
    return h * jax.nn.gelu(gate.astype(F32))


def _swiglu(h, w13, w2):
    a, b = jnp.split(h @ w13, 2, axis=-1)
    return (jax.nn.silu(a) * b) @ w2


def setup_inputs(seed: int = 0) -> dict:
    key = jax.random.key(seed)
    ks = iter(jax.random.split(key, 48))
    L = DEPTH

    def nrm(shape, scale):
        return scale * jax.random.normal(next(ks), shape, F32)

    def unif(shape, lo, hi):
        return jax.random.uniform(next(ks), shape, F32, lo, hi)

    def dt_bias(shape):
        dt = jnp.exp(unif(shape, math.log(DT_MIN), math.log(DT_MAX)))
        return dt + jnp.log(-jnp.expm1(-dt))

    a0 = unif((L, LRU_WIDTH), 0.9, 0.999) ** (1.0 / LRU_C)
    return {
        "x": nrm((BATCH, SEQ, D_MODEL), 1.0),
        "c": nrm((BATCH, D_MODEL), 1.0),
        "ln_mix_g": 1.0 + nrm((L, D_MODEL), 0.02),
        "ln_ffn_g": 1.0 + nrm((L, D_MODEL), 0.02),
        "ln_final_g": 1.0 + nrm((D_MODEL,), 0.02),
        "ada_w": nrm((L, D_MODEL, 6 * D_MODEL), D_MODEL ** -0.5),
        "ada_b": nrm((L, 6 * D_MODEL), 0.01),
        "w_in": nrm((L, D_MODEL, IN_COLS), D_MODEL ** -0.5),
        "conv_w": nrm((L, CONV_K, CONV_CH), CONV_K ** -0.5),
        "conv_b": nrm((L, CONV_CH), 0.01),
        "s5_lambda_re": -0.5 + nrm((L, S5_GROUPS, S5_STATE), 0.01),
        "s5_lambda_im": jnp.pi * jnp.arange(S5_STATE, dtype=F32) + nrm((L, S5_GROUPS, S5_STATE), 0.01),
        "s5_log_dt": unif((L, S5_GROUPS), math.log(DT_MIN), math.log(DT_MAX)),
        "s5_b_re": nrm((L, S5_GROUPS, S5_STATE, S5_GROUP), (2 * S5_GROUP) ** -0.5),
        "s5_b_im": nrm((L, S5_GROUPS, S5_STATE, S5_GROUP), (2 * S5_GROUP) ** -0.5),
        "s5_c_re": nrm((L, S5_GROUPS, S5_GROUP, S5_STATE), (2 * S5_STATE) ** -0.5),
        "s5_c_im": nrm((L, S5_GROUPS, S5_GROUP, S5_STATE), (2 * S5_STATE) ** -0.5),
        "s5_d": nrm((L, S5_WIDTH), 1.0),
        "s5_glu_w": nrm((L, S5_WIDTH, S5_WIDTH), S5_WIDTH ** -0.5),
        "s5_glu_b": nrm((L, S5_WIDTH), 0.01),
        "gdn_a_log": jnp.log(unif((L, GDN_HEADS), 1.0, 16.0)),
        "gdn_dt_bias": dt_bias((L, GDN_HEADS)),
        "gdn_norm_w": 1.0 + nrm((L, GDN_DV), 0.02),
        "ssd_a_log": jnp.log(unif((L, SSD_HEADS), 1.0, 16.0)),
        "ssd_dt_bias": dt_bias((L, SSD_HEADS)),
        "ssd_d": 1.0 + nrm((L, SSD_HEADS), 0.1),
        "ssd_norm_w": 1.0 + nrm((L, SSD_WIDTH), 0.02),
        "lru_lambda": jnp.log(a0) - jnp.log1p(-a0),
        "lru_wr": nrm((L, LRU_BLOCKS, LRU_BLOCK, LRU_BLOCK), LRU_BLOCK ** -0.5),
        "lru_br": nrm((L, LRU_WIDTH), 0.01),
        "lru_wi": nrm((L, LRU_BLOCKS, LRU_BLOCK, LRU_BLOCK), LRU_BLOCK ** -0.5),
        "lru_bi": nrm((L, LRU_WIDTH), 0.01),
        "w_branch": nrm((L, MIX_WIDTH, D_MODEL), GDN_WIDTH ** -0.5),
        "w_out": nrm((L, D_MODEL, D_MODEL), D_MODEL ** -0.5),
        "ffn_w13": nrm((L, D_MODEL, 2 * FFN_HIDDEN), D_MODEL ** -0.5),
        "ffn_w2": nrm((L, FFN_HIDDEN, D_MODEL), FFN_HIDDEN ** -0.5),
    }


def reference(x, c, ln_mix_g, ln_ffn_g, ln_final_g, ada_w, ada_b, w_in, conv_w, conv_b,
              s5_lambda_re, s5_lambda_im, s5_log_dt, s5_b_re, s5_b_im, s5_c_re, s5_c_im,
              s5_d, s5_glu_w, s5_glu_b, gdn_a_log, gdn_dt_bias, gdn_norm_w,
              ssd_a_log, ssd_dt_bias, ssd_d, ssd_norm_w,
              lru_lambda, lru_wr, lru_br, lru_wi, lru_bi,
              w_branch, w_out, ffn_w13, ffn_w2):
    bsz, seq_len, _ = x.shape
    cond = jax.nn.silu(c)
    for l in range(DEPTH):
        mod = (cond @ ada_w[l] + ada_b[l])[:, None, :]
        sh_m, sc_m, gt_m, sh_f, sc_f, gt_f = jnp.split(mod, 6, axis=-1)

        h = (_rms(x) * ln_mix_g[l] * (1.0 + sc_m) + sh_m).astype(x.dtype)
        proj = h @ w_in[l]
        xc = _causal_conv(proj[..., :CONV_CH], conv_w[l], conv_b[l])
        q, k, v, x_ssd, b_ssd, c_ssd = _split(jax.nn.silu(xc[..., :CONV_SILU_CH]), CONV_SILU_WIDTHS)
        x_lru = xc[..., CONV_SILU_CH:]
        u_s5, b_gdn, a_gdn, z_gdn, z_ssd, dt_ssd, g_lru, g_merge = _split(proj[..., CONV_CH:], REST_WIDTHS)

        y_a = _s5_branch(u_s5, s5_lambda_re[l], s5_lambda_im[l], s5_log_dt[l], s5_b_re[l], s5_b_im[l],
                         s5_c_re[l], s5_c_im[l], s5_d[l], s5_glu_w[l], s5_glu_b[l])
        y_b = _gdn_branch(q, k, v, b_gdn, a_gdn, z_gdn, gdn_a_log[l], gdn_dt_bias[l], gdn_norm_w[l])
        y_c = _ssd_branch(x_ssd, b_ssd, c_ssd, z_ssd, dt_ssd, ssd_a_log[l], ssd_dt_bias[l], ssd_d[l], ssd_norm_w[l])
        y_d = _rglru_branch(x_lru, g_lru, lru_lambda[l], lru_wr[l], lru_br[l], lru_wi[l], lru_bi[l])

        gates = jax.nn.sigmoid(g_merge.astype(F32)).reshape(bsz, seq_len, N_BRANCH, D_MODEL)
        rows = _split(w_branch[l], BRANCH_WIDTHS, axis=0)
        merged = (gates[:, :, 0] * (y_a @ rows[0]) + gates[:, :, 1] * (y_b @ rows[1])
                  + gates[:, :, 2] * (y_c @ rows[2]) + gates[:, :, 3] * (y_d @ rows[3]))
        x = x + gt_m * (merged @ w_out[l]).astype(x.dtype)

        h = (_rms(x) * ln_ffn_g[l] * (1.0 + sc_f) + sh_f).astype(x.dtype)
        x = x + gt_f * _swiglu(h, ffn_w13[l], ffn_w2[l]).astype(x.dtype)
    return (_rms(x) * ln_final_g).astype(x.dtype)
```

```cpp
#include <hip/hip_runtime.h>
#include <hip/hip_cooperative_groups.h>
#include <cstdio>
namespace cg = cooperative_groups;

#define LAS __attribute__((address_space(3)))
typedef unsigned short bf16_t;
typedef short bf16x8 __attribute__((ext_vector_type(8)));
typedef float f32x4 __attribute__((ext_vector_type(4)));
typedef float f32x2 __attribute__((ext_vector_type(2)));
typedef unsigned u32x2 __attribute__((ext_vector_type(2)));
typedef unsigned u32x4 __attribute__((ext_vector_type(4)));

constexpr int T_ = 32768, D_ = 1024, NB = 8, SEQ = 4096, NCH = 64, PC = 4752, INC = 8848, CONVC = 2816, FH = 2816;
constexpr int OQ = 0, OKK = 512, OV = 1024, OXS = 1536, OBS = 2048, OCS = 2176, OXL = 2304, OU5 = 2816, OBG = 3200, OAG = 3204, OZG = 3208, OZS = 3720, ODT = 4232, OGL = 4240;
constexpr size_t WS_BTIN = 0, WS_BTBR = 18120704, WS_BTOUT = 22052864, WS_BT13 = 24150016, WS_BT2 = 35684352, WS_H = 41451520, WS_M = 108560384,
                 WS_PROJ = 175669248, WS_HALO = 487096320, WS_MOD = 495747072, WS_DT = 496140288, WS_CS = 497188864, WS_GC = 498237440, WS_S5C = 498761728,
                 WS_LA = 505053184, WS_LH = 506101760, WS_PAR = 507150336, WS_END = 507150336 + 1024 * 512;
constexpr int LDS_BYTES = 160 * 1024;

struct Params {
    const float* in[36];
    float* out;
    unsigned char* ws;
};

__device__ __forceinline__ int otid() { int t = threadIdx.x; asm volatile("" : "+v"(t)); return t; }
__device__ __forceinline__ int obid() { int t = blockIdx.x; asm volatile("" : "+s"(t)); return t; }
struct Params;
__device__ __forceinline__ const Params* kparams() { auto k = __builtin_amdgcn_kernarg_segment_ptr(); asm volatile("" : "+s"(k)); return (const Params*)k; }
__device__ __forceinline__ int ogrid() { int t = gridDim.x; asm volatile("" : "+s"(t)); return t; }
__device__ __forceinline__ float bf2f(bf16_t v) { return __uint_as_float(((unsigned)v) << 16); }
__device__ __forceinline__ bf16_t f2bf(float f) { unsigned r; asm("v_cvt_pk_bf16_f32 %0, %1, %1" : "=v"(r) : "v"(f)); return (bf16_t)(r & 0xffffu); }
__device__ __forceinline__ unsigned pk2(float lo, float hi) { unsigned r; asm("v_cvt_pk_bf16_f32 %0, %1, %2" : "=v"(r) : "v"(lo), "v"(hi)); return r; }
__device__ __forceinline__ float sigmoidf_(float x) { return __builtin_amdgcn_rcpf(1.0f + __expf(-x)); }
__device__ __forceinline__ float siluf_(float x) { return x * __builtin_amdgcn_rcpf(1.0f + __expf(-x)); }
__device__ __forceinline__ float softplusf_(float x) { return fmaxf(x, 0.f) + log1pf(__expf(-fabsf(x))); }
__device__ __forceinline__ float geluf_(float x) { const float u = 0.7978845608028654f * (x + 0.044715f * x * x * x); return x - x * __builtin_amdgcn_rcpf(1.0f + __expf(2.0f * u)); }
__device__ __forceinline__ int pperm(int d) { return (d & ~31) | (((d >> 2) & 3) << 3) | (((d >> 4) & 1) << 2) | (d & 3); }
__device__ __forceinline__ int iperm(int q) { return (q & ~31) | (((q >> 2) & 1) << 4) | (((q >> 3) & 3) << 2) | (q & 3); }
__device__ __forceinline__ bf16x8 pack8(const f32x4 a, const f32x4 b) { u32x4 r; r.x = pk2(a[0], a[1]); r.y = pk2(a[2], a[3]); r.z = pk2(b[0], b[1]); r.w = pk2(b[2], b[3]); return __builtin_bit_cast(bf16x8, r); }
__device__ __forceinline__ f32x4 up4(u32x2 v) { f32x4 r; r[0] = __uint_as_float(v.x << 16); r[1] = __uint_as_float(v.x & 0xffff0000u); r[2] = __uint_as_float(v.y << 16); r[3] = __uint_as_float(v.y & 0xffff0000u); return r; }
__device__ __forceinline__ float wave_incl_scan(float v, int lane) {
#pragma unroll
    for (int o = 1; o < 64; o <<= 1) { const float t = __shfl_up(v, o); if (lane >= o) v += t; }
    return v;
}
__device__ __forceinline__ float wave_sum(float v) {
#pragma unroll
    for (int o = 32; o > 0; o >>= 1) v += __shfl_xor(v, o);
    return v;
}

constexpr int HTB = 128 * 64 * 2;
__device__ __forceinline__ int lds_byte(int r, int c) { const int st = (r >> 4) * 2 + (c >> 5), rr = r & 15, cc = c & 31, ob = rr * 64 + cc * 2; return st * 1024 + (ob ^ (((ob >> 9) & 1) << 5)); }
__device__ __forceinline__ void stage_rc(int b, int& R, int& C) { const int st = b / 1024, sb = b % 1024, swz = sb ^ (((sb >> 9) & 1) << 5); R = (st >> 1) * 16 + swz / 64; C = (st & 1) * 32 + (swz % 64) / 2; }

__device__ __forceinline__ int perm32(int rho) { const int n = rho >> 4, i = rho & 15; return 8 * (i >> 2) + 4 * n + (i & 3); }
struct GU { const char* A; const char* B; int lda; int nt; int pm, pn, sub; };

struct TileOrder {
    int nM, nN, nwg, G, c;
    __device__ void init(int nM_, int nN_, int G_, int c_) { nM = nM_; nN = nN_; nwg = nM * nN; G = G_; c = c_; }
    __device__ bool tile(int i, int& pm, int& pn) const {
        const long L = (long)i * G + c; if (L >= nwg) return false;
        int wgid = (int)L; { const int q = nwg / 8, r = nwg % 8, xcd = wgid % 8, off = wgid / 8; wgid = (xcd < r ? xcd * (q + 1) : r * (q + 1) + (xcd - r) * q) + off; }
        const int nig = 8 * nN, gid = wgid / nig, fm = gid * 8, gsz = (nM - fm) < 8 ? (nM - fm) : 8;
        pm = fm + ((wgid % nig) % gsz); pn = (wgid % nig) / gsz; return true;
    }
};

template <class P>
__device__ __forceinline__ void gemm_run(LAS unsigned char* lds, const P& prog) {
    const int tid = otid(), wid = __builtin_amdgcn_readfirstlane(tid >> 6), lane = tid & 63, wr = wid >> 2, wc = wid & 3, fr = lane & 15, fq = lane >> 4;
    const unsigned ldsw = (unsigned)wid * 1024u;
    const int aoff = lds_byte(wr * 64 + fr, fq * 8), boff = lds_byte(wc * 32 + fr, fq * 8);
#define G_SA(b, h) (((b) * 2 + (h)) * HTB)
#define G_SB(b, h) ((4 + (b) * 2 + (h)) * HTB)
#define G_STAGE(bufoff, gbase, voff) do { _Pragma("unroll") for (int _i = 0; _i < 2; ++_i) \
        __builtin_amdgcn_global_load_lds((const unsigned*)((const char*)(gbase) + (voff)[_i]), (LAS unsigned*)(lds + (bufoff) + ldsw + _i * 8192), 16, 0, 0); } while (0)
#define G_LDA(dst, b, h) do { _Pragma("unroll") for (int m = 0; m < 4; ++m) _Pragma("unroll") for (int k = 0; k < 2; ++k) dst[m][k] = *(const LAS bf16x8*)(lds + G_SA(b, h) + aoff + m * 2048 + k * 1024); } while (0)
#define G_LDB(dst, b, h) do { _Pragma("unroll") for (int n = 0; n < 2; ++n) _Pragma("unroll") for (int k = 0; k < 2; ++k) dst[n][k] = *(const LAS bf16x8*)(lds + G_SB(b, h) + boff + n * 2048 + k * 1024); } while (0)
#define G_MMA(ai, bj, At, Bt) do { __builtin_amdgcn_s_setprio(1); _Pragma("unroll") for (int m = 0; m < 4; ++m) _Pragma("unroll") for (int n = 0; n < 2; ++n) _Pragma("unroll") for (int k = 0; k < 2; ++k) \
        acc[ai][bj][m][n] = __builtin_amdgcn_mfma_f32_16x16x32_bf16(Bt[n][k], At[m][k], acc[ai][bj][m][n], 0, 0, 0); __builtin_amdgcn_s_setprio(0); } while (0)
#define G_WAIT_V(n) asm volatile("s_waitcnt vmcnt(" #n ")" ::: "memory")
#define G_WAIT_L(n) asm volatile("s_waitcnt lgkmcnt(" #n ")" ::: "memory")
#define G_BAR __builtin_amdgcn_s_barrier()
#define G_SCHED __builtin_amdgcn_sched_barrier(0)
    GU cur, nxt; int ui = 0;
    if (!prog.get(0, cur)) return;
    f32x4 acc[2][2][4][2];
#pragma unroll
    for (int a = 0; a < 2; ++a)
#pragma unroll
        for (int b = 0; b < 2; ++b)
#pragma unroll
            for (int m = 0; m < 4; ++m)
#pragma unroll
                for (int n = 0; n < 2; ++n) acc[a][b][m][n] = (f32x4){0.f, 0.f, 0.f, 0.f};
    bf16x8 At[4][2], B0[2][2], B1[2][2];
    unsigned cvA[2], cvB[2], nvA[2], nvB[2];
#pragma unroll
    for (int i = 0; i < 2; ++i) { int R, C; stage_rc(tid * 16 + i * 8192, R, C); const int Rb = 64 * (R >> 5) + perm32(R & 31); cvA[i] = (unsigned)(R * cur.lda + C) * 2u; cvB[i] = (unsigned)(Rb * cur.nt * 64 + C) * 2u; }
    unsigned chA = 256u * cur.lda, chB = 64u * cur.nt * 64;
    const size_t kstep = 128;
    const char* cA = cur.A; const char* cB = cur.B;
    G_STAGE(G_SB(0, 0), cB, cvB); G_STAGE(G_SA(0, 0), cA, cvA); G_STAGE(G_SB(0, 1), cB + chB, cvB); G_STAGE(G_SA(0, 1), cA + chA, cvA);
    if (wr == 1) G_BAR;
    G_WAIT_V(4); G_BAR;
    G_STAGE(G_SB(1, 0), cB + kstep, cvB); G_STAGE(G_SA(1, 0), cA + kstep, cvA); G_STAGE(G_SB(1, 1), cB + chB + kstep, cvB);
    G_WAIT_V(6); G_BAR;
    for (;;) {
        const bool has_next = prog.get(ui + 1, nxt);
        if (!has_next) nxt = cur;
        const char* nA = nxt.A; const char* nB = nxt.B;
        { int t2 = tid; asm volatile("" : "+v"(t2));
#pragma unroll
          for (int i = 0; i < 2; ++i) { int R, C; stage_rc(t2 * 16 + i * 8192, R, C); const int Rb = 64 * (R >> 5) + perm32(R & 31); nvA[i] = (unsigned)(R * nxt.lda + C) * 2u; nvB[i] = (unsigned)(Rb * nxt.nt * 64 + C) * 2u; } }
        const unsigned nhA = 256u * nxt.lda, nhB = 64u * nxt.nt * 64;
        const int nt = cur.nt;
        for (int t = 0; t < nt; t += 2) {
            const bool last = (t == nt - 2);
            const char* a1 = cA + (size_t)(t + 1) * kstep;
            const char* a2 = last ? nA : cA + (size_t)(t + 2) * kstep; const char* b2 = last ? nB : cB + (size_t)(t + 2) * kstep;
            const char* a3 = a2 + kstep; const char* b3 = b2 + kstep;
            unsigned vA2[2], vB2[2];
#pragma unroll
            for (int i = 0; i < 2; ++i) { vA2[i] = last ? nvA[i] : cvA[i]; vB2[i] = last ? nvB[i] : cvB[i]; }
            const unsigned hA2 = last ? nhA : chA, hB2 = last ? nhB : chB;
            G_LDB(B0, 0, 0); G_SCHED; G_LDA(At, 0, 0); G_STAGE(G_SA(1, 1), a1 + chA, cvA);
            G_WAIT_L(8); G_BAR; G_WAIT_L(0); G_MMA(0, 0, At, B0); G_BAR; G_SCHED;
            G_LDB(B1, 0, 1); G_STAGE(G_SB(0, 0), b2, vB2);
            G_BAR; G_WAIT_L(0); G_MMA(0, 1, At, B1); G_BAR;
            G_LDA(At, 0, 1); G_STAGE(G_SA(0, 0), a2, vA2);
            G_BAR; G_WAIT_L(0); G_MMA(1, 0, At, B0); G_BAR; G_SCHED;
            G_STAGE(G_SB(0, 1), b2 + hB2, vB2);
            G_WAIT_V(6); G_BAR; G_MMA(1, 1, At, B1); G_BAR;
            G_LDB(B0, 1, 0); G_SCHED; G_LDA(At, 1, 0); G_STAGE(G_SA(0, 1), a2 + hA2, vA2);
            G_WAIT_L(8); G_BAR; G_WAIT_L(0); G_MMA(0, 0, At, B0); G_BAR; G_SCHED;
            G_LDB(B1, 1, 1); G_STAGE(G_SB(1, 0), b3, vB2);
            G_BAR; G_WAIT_L(0); G_MMA(0, 1, At, B1); G_BAR;
            G_LDA(At, 1, 1); G_STAGE(G_SA(1, 0), a3, vA2);
            G_BAR; G_WAIT_L(0); G_MMA(1, 0, At, B0); G_BAR; G_SCHED;
            G_STAGE(G_SB(1, 1), b3 + hB2, vB2);
            G_WAIT_V(6); G_BAR; G_MMA(1, 1, At, B1); G_BAR;
        }
        prog.epi(acc, cur, wr, wc, fr, fq);
        if (!has_next) break;
#pragma unroll
        for (int a = 0; a < 2; ++a)
#pragma unroll
            for (int b = 0; b < 2; ++b)
#pragma unroll
                for (int m = 0; m < 4; ++m)
#pragma unroll
                    for (int n = 0; n < 2; ++n) acc[a][b][m][n] = (f32x4){0.f, 0.f, 0.f, 0.f};
        cur = nxt; cA = nA; cB = nB; chA = nhA; chB = nhB;
#pragma unroll
        for (int i = 0; i < 2; ++i) { cvA[i] = nvA[i]; cvB[i] = nvB[i]; }
        ++ui;
    }
    G_WAIT_V(0);
    if (wr == 0) G_BAR;
    G_BAR;
#undef G_SA
#undef G_SB
#undef G_STAGE
#undef G_LDA
#undef G_LDB
#undef G_MMA
#undef G_WAIT_V
#undef G_WAIT_L
#undef G_BAR
#undef G_SCHED
}

struct ProgProj {
    TileOrder ord; const char* A; const char* B; bf16_t* proj; bf16_t* halo;
    __device__ bool get(int i, GU& u) const { if (!ord.tile(i, u.pm, u.pn)) return false; u.A = A + (size_t)u.pm * 256 * 1024 * 2; u.B = B + (size_t)u.pn * 256 * 1024 * 2; u.lda = 1024; u.nt = 16; u.sub = 0; return true; }
    __device__ __forceinline__ void epi(const f32x4 (&acc)[2][2][4][2], const GU& u, int wr, int wc, int fr, int fq) const {
#pragma unroll
        for (int ai = 0; ai < 2; ++ai)
#pragma unroll
            for (int m = 0; m < 4; ++m) {
                const int row = u.pm * 256 + ai * 128 + wr * 64 + m * 16 + fr;
                const int r6 = row & 63;
#pragma unroll
                for (int bj = 0; bj < 2; ++bj) {
                    const int col = u.pn * 256 + wc * 64 + bj * 32 + 8 * fq;
                    const f32x4 v0 = acc[ai][bj][m][0], v1 = acc[ai][bj][m][1];
                    u32x4 pk; pk.x = pk2(v0[0], v0[1]); pk.y = pk2(v0[2], v0[3]); pk.z = pk2(v1[0], v1[1]); pk.w = pk2(v1[2], v1[3]);
                    if (col < PC) *(u32x4*)(proj + (size_t)row * PC + col) = pk;
                    if (col < CONVC && r6 >= 61) *(u32x4*)(halo + ((size_t)(row >> 6) * 3 + (r6 - 61)) * CONVC + col) = pk;
                }
            }
    }
};

struct ProgMerge {
    TileOrder ord; const char* H; const char* Bg; const char* Bb; const char* P; bf16_t* proj; bf16_t* mb;
    __device__ bool get(int i, GU& u) const {
        const int tl = i >> 3, sub = i & 7;
        if (!ord.tile(tl, u.pm, u.pn)) return false;
        u.sub = sub; const int br = sub >> 1;
        if (!(sub & 1)) { u.A = H + (size_t)u.pm * 256 * 1024 * 2; u.lda = 1024; u.nt = 16; u.B = Bg + ((size_t)br * 1024 + (size_t)u.pn * 256) * 1024 * 2; }
        else {
            const int kb = (br == 0) ? 384 : 512; const int ycol = (br == 0) ? OU5 : (br == 1) ? OV : (br == 2) ? OXS : OXL; const int koff = (br == 0) ? 0 : 384 + (br - 1) * 512;
            u.A = P + ((size_t)u.pm * 256 * PC + ycol) * 2; u.lda = PC; u.nt = kb / 64; u.B = Bb + (size_t)koff * 1024 * 2 + (size_t)u.pn * 256 * kb * 2;
        }
        return true;
    }
    __device__ __forceinline__ void epi(const f32x4 (&acc)[2][2][4][2], const GU& u, int wr, int wc, int fr, int fq) const {
        const int sub = u.sub;
#pragma unroll
        for (int ai = 0; ai < 2; ++ai)
#pragma unroll
            for (int m = 0; m < 4; ++m) {
                const int row = u.pm * 256 + ai * 128 + wr * 64 + m * 16 + fr;
#pragma unroll
                for (int bj = 0; bj < 2; ++bj) {
                    const int col = u.pn * 256 + wc * 64 + bj * 32 + 8 * fq;
                    const f32x4 v0 = acc[ai][bj][m][0], v1 = acc[ai][bj][m][1];
                    bf16_t* st = proj + (size_t)row * PC + col;
                    bf16_t* mp = mb + (size_t)row * 1024 + col;
                    if (!(sub & 1)) {
                        u32x4 pk; pk.x = pk2(sigmoidf_(v0[0]), sigmoidf_(v0[1])); pk.y = pk2(sigmoidf_(v0[2]), sigmoidf_(v0[3])); pk.z = pk2(sigmoidf_(v1[0]), sigmoidf_(v1[1])); pk.w = pk2(sigmoidf_(v1[2]), sigmoidf_(v1[3]));
                        *(u32x4*)st = pk;
                    } else {
                        const u32x4 g = *(const u32x4*)st;
                        f32x4 r0 = up4((u32x2){g.x, g.y}) * v0, r1 = up4((u32x2){g.z, g.w}) * v1;
                        if (sub > 1) { const u32x4 o = *(const u32x4*)mp; r0 = r0 + up4((u32x2){o.x, o.y}); r1 = r1 + up4((u32x2){o.z, o.w}); }
                        u32x4 pk; pk.x = pk2(r0[0], r0[1]); pk.y = pk2(r0[2], r0[3]); pk.z = pk2(r1[0], r1[1]); pk.w = pk2(r1[2], r1[3]);
                        *(u32x4*)mp = pk;
                    }
                }
            }
    }
};

struct ProgRes {
    TileOrder ord; const char* A; const char* B; int lda, nt; const float* xin; float* xout; const float* gt;
    __device__ bool get(int i, GU& u) const { if (!ord.tile(i, u.pm, u.pn)) return false; u.A = A + (size_t)u.pm * 256 * lda * 2; u.B = B + (size_t)u.pn * 256 * (nt * 64) * 2; u.lda = lda; u.nt = nt; u.sub = 0; return true; }
    __device__ __forceinline__ void epi(const f32x4 (&acc)[2][2][4][2], const GU& u, int wr, int wc, int fr, int fq) const {
        const int bidx = (u.pm * 256) >> 12;
#pragma unroll
        for (int bj = 0; bj < 2; ++bj)
#pragma unroll
            for (int n = 0; n < 2; ++n) {
                const int col = u.pn * 256 + wc * 64 + bj * 32 + 8 * fq + 4 * n;
                const f32x4 g = *(const f32x4*)(gt + (size_t)bidx * 6144 + col);
#pragma unroll
                for (int ai = 0; ai < 2; ++ai)
#pragma unroll
                    for (int mp = 0; mp < 2; ++mp) {
                        const int row0 = u.pm * 256 + ai * 128 + wr * 64 + (2 * mp) * 16 + fr, row1 = row0 + 16;
                        const f32x4 xa = *(const f32x4*)(xin + (size_t)row0 * 1024 + col), xb2 = *(const f32x4*)(xin + (size_t)row1 * 1024 + col);
                        *(f32x4*)(xout + (size_t)row0 * 1024 + col) = xa + g * acc[ai][bj][2 * mp][n];
                        *(f32x4*)(xout + (size_t)row1 * 1024 + col) = xb2 + g * acc[ai][bj][2 * mp + 1][n];
                    }
            }
    }
};

struct ProgSwi {
    TileOrder ord; const char* A; const char* B; bf16_t* act;
    __device__ bool get(int i, GU& u) const { if (!ord.tile(i, u.pm, u.pn)) return false; u.A = A + (size_t)u.pm * 256 * 1024 * 2; u.B = B + (size_t)u.pn * 256 * 1024 * 2; u.lda = 1024; u.nt = 16; u.sub = 0; return true; }
    __device__ __forceinline__ void epi(const f32x4 (&acc)[2][2][4][2], const GU& u, int wr, int wc, int fr, int fq) const {
#pragma unroll
        for (int ai = 0; ai < 2; ++ai)
#pragma unroll
            for (int m = 0; m < 4; ++m) {
                const int row = u.pm * 256 + ai * 128 + wr * 64 + m * 16 + fr;
                const int col = u.pn * 128 + wc * 32 + 8 * fq;
                const f32x4 a0 = acc[ai][0][m][0], b0 = acc[ai][1][m][0], a1 = acc[ai][0][m][1], b1 = acc[ai][1][m][1];
                u32x4 pk; pk.x = pk2(siluf_(a0[0]) * b0[0], siluf_(a0[1]) * b0[1]); pk.y = pk2(siluf_(a0[2]) * b0[2], siluf_(a0[3]) * b0[3]);
                pk.z = pk2(siluf_(a1[0]) * b1[0], siluf_(a1[1]) * b1[1]); pk.w = pk2(siluf_(a1[2]) * b1[2], siluf_(a1[3]) * b1[3]);
                *(u32x4*)(act + (size_t)row * FH + col) = pk;
            }
    }
};

struct CDesc { const float* src; bf16_t* dst; int ld_src, k0, n0, nmax, ld_dst, mode; };
__device__ __forceinline__ void convert_decode(const Params& p, int l, int it, CDesc& d) {
    int j, r = it;
    if (r < 2224) j = 0; else if (r < 2320) { j = 1; r -= 2224; } else if (r < 2448) { j = 2; r -= 2320; } else if (r < 2576) { j = 3; r -= 2448; } else if (r < 2704) { j = 4; r -= 2576; }
    else if (r < 2960) { j = 5; r -= 2704; } else if (r < 4368) { j = 6; r -= 2960; } else if (r < 5072) { j = 7; r -= 4368; } else if (r < 5108) { j = 8; r -= 5072; } else { j = 9; r -= 5108; }
    int KT; d.mode = 0;
    if (j == 0) { d.src = p.in[7] + (size_t)l * 1024 * INC; d.ld_src = INC; KT = 16; d.nmax = INC; d.dst = (bf16_t*)(p.ws + WS_BTIN); d.ld_dst = 1024; }
    else if (j <= 4) { const int br = j - 1; const int kb = br == 0 ? 384 : 512, koff = br == 0 ? 0 : 384 + (br - 1) * 512;
        d.src = p.in[32] + (size_t)l * 1920 * 1024 + (size_t)koff * 1024; d.ld_src = 1024; KT = kb / 64; d.nmax = 1024; d.dst = (bf16_t*)(p.ws + WS_BTBR) + (size_t)koff * 1024; d.ld_dst = kb; }
    else if (j == 5) { d.src = p.in[33] + (size_t)l * 1024 * 1024; d.ld_src = 1024; KT = 16; d.nmax = 1024; d.dst = (bf16_t*)(p.ws + WS_BTOUT); d.ld_dst = 1024; }
    else if (j == 6) { d.src = p.in[34] + (size_t)l * 1024 * 5632; d.ld_src = 5632; KT = 16; d.nmax = 5632; d.dst = (bf16_t*)(p.ws + WS_BT13); d.ld_dst = 1024; d.mode = 1; }
    else if (j == 7) { d.src = p.in[35] + (size_t)l * FH * 1024; d.ld_src = 1024; KT = 44; d.nmax = 1024; d.dst = (bf16_t*)(p.ws + WS_BT2); d.ld_dst = FH; }
    else if (j == 8) { d.src = p.in[18] + (size_t)l * 384 * 384; d.ld_src = 384; KT = 6; d.nmax = 384; d.dst = (bf16_t*)(p.ws + WS_PAR); d.ld_dst = 384; }
    else { const int gate = r >> 3, nb = r & 7; d.src = (gate ? p.in[30] : p.in[28]) + (size_t)(l * 8 + nb) * 4096; d.ld_src = 64; KT = 1; d.nmax = 64; d.dst = (bf16_t*)(p.ws + WS_PAR + 294912) + (size_t)(gate * 8 + nb) * 4096; d.ld_dst = 64; r = 0; }
    d.n0 = (r / KT) * 64; d.k0 = (r % KT) * 64;
}
__device__ __forceinline__ void convert_layer(const Params& p, int l, float* sm) {
    const int total = 5124;
    const int tid = otid(), G = ogrid();
    int it = obid();
    if (it >= total) return;
    CDesc d; convert_decode(p, l, it, d);
    float v[8];
    {
        const int nn = tid & 63, n = d.n0 + nn;
#pragma unroll
        for (int i = 0; i < 8; ++i) { const int kk = (tid >> 6) + 8 * i; v[i] = (n < d.nmax) ? d.src[(size_t)(d.k0 + kk) * d.ld_src + n] : 0.f; }
    }
    int buf = 0;
    for (;;) {
        float* T = sm + buf * 4160;
        {
            const int nn = tid & 63;
#pragma unroll
            for (int i = 0; i < 8; ++i) { const int kk = (tid >> 6) + 8 * i; T[kk * 65 + nn] = v[i]; }
        }
        const bool has_next = (it + G < total);
        CDesc dn = d;
        if (has_next) {
            convert_decode(p, l, it + G, dn);
            const int nn = tid & 63, n = dn.n0 + nn;
#pragma unroll
            for (int i = 0; i < 8; ++i) { const int kk = (tid >> 6) + 8 * i; v[i] = (n < dn.nmax) ? dn.src[(size_t)(dn.k0 + kk) * dn.ld_src + n] : 0.f; }
        }
        __syncthreads();
        {
            const int nn2 = tid >> 3, kk2 = (tid & 7) * 8, n = d.n0 + nn2;
            if (n < d.nmax) {
                int row = n;
                if (d.mode == 1) row = (n < FH) ? ((n >> 5) * 64 + (n & 31)) : ((((n - FH) >> 5) * 64) + 32 + ((n - FH) & 31));
                u32x4 pk;
                pk.x = pk2(T[(kk2 + 0) * 65 + nn2], T[(kk2 + 1) * 65 + nn2]); pk.y = pk2(T[(kk2 + 2) * 65 + nn2], T[(kk2 + 3) * 65 + nn2]);
                pk.z = pk2(T[(kk2 + 4) * 65 + nn2], T[(kk2 + 5) * 65 + nn2]); pk.w = pk2(T[(kk2 + 6) * 65 + nn2], T[(kk2 + 7) * 65 + nn2]);
                *(u32x4*)(d.dst + (size_t)row * d.ld_dst + d.k0 + kk2) = pk;
            }
        }
        if (!has_next) break;
        d = dn; it += G; buf ^= 1;
    }
    __syncthreads();
}

__device__ __forceinline__ void mod_phase(const Params& p, float* sm) {
    float* cond = sm;
    float* part = sm + 8192;
    float* mod = (float*)(p.ws + WS_MOD);
    const int tid = otid();
    for (int it = obid(); it < 96; it += ogrid()) {
        const int l = it / 48, cb = it % 48;
        for (int i = tid; i < 8192; i += 512) cond[i] = siluf_(p.in[1][i]);
        __syncthreads();
        const int cl = tid & 127, ks = tid >> 7, col = cb * 128 + cl;
        float a[8];
#pragma unroll
        for (int b = 0; b < 8; ++b) a[b] = 0.f;
        const float* w = p.in[5] + (size_t)l * 1024 * 6144 + col;
#pragma unroll 2
        for (int k = ks * 256; k < ks * 256 + 256; k += 4) {
            const float w0 = w[(size_t)k * 6144], w1 = w[(size_t)(k + 1) * 6144], w2 = w[(size_t)(k + 2) * 6144], w3 = w[(size_t)(k + 3) * 6144];
#pragma unroll
            for (int b = 0; b < 8; ++b) { const f32x4 c4 = *(const f32x4*)(cond + b * 1024 + k); a[b] += c4[0] * w0 + c4[1] * w1 + c4[2] * w2 + c4[3] * w3; }
        }
#pragma unroll
        for (int b = 0; b < 8; ++b) part[(ks * 8 + b) * 128 + cl] = a[b];
        __syncthreads();
        for (int i = tid; i < 1024; i += 512) {
            const int b = i >> 7, c2 = i & 127;
            const float s = part[(0 * 8 + b) * 128 + c2] + part[(1 * 8 + b) * 128 + c2] + part[(2 * 8 + b) * 128 + c2] + part[(3 * 8 + b) * 128 + c2];
            mod[((size_t)l * 8 + b) * 6144 + cb * 128 + c2] = s + p.in[6][(size_t)l * 6144 + cb * 128 + c2];
        }
        __syncthreads();
    }
}

__device__ __forceinline__ void norm_phase(const float* src, const float* g, const float* modl, int sh_off, int sc_off, bf16_t* dst) {
    const int tid = otid(), wid = __builtin_amdgcn_readfirstlane(tid >> 6), lane = tid & 63;
    const int stride = ogrid() * 8;
    int row = obid() * 8 + wid;
    if (row >= T_) return;
    f32x4 gg[4];
#pragma unroll
    for (int j = 0; j < 4; ++j) gg[j] = *(const f32x4*)(g + lane * 4 + 256 * j);
    f32x4 vn[4];
#pragma unroll
    for (int j = 0; j < 4; ++j) vn[j] = *(const f32x4*)(src + (size_t)row * 1024 + lane * 4 + 256 * j);
    for (; row < T_; row += stride) {
        const int b = row >> 12;
        f32x4 v[4]; float ss = 0.f;
#pragma unroll
        for (int j = 0; j < 4; ++j) { v[j] = vn[j]; ss += v[j][0] * v[j][0] + v[j][1] * v[j][1] + v[j][2] * v[j][2] + v[j][3] * v[j][3]; }
        if (row + stride < T_) {
#pragma unroll
            for (int j = 0; j < 4; ++j) vn[j] = *(const f32x4*)(src + (size_t)(row + stride) * 1024 + lane * 4 + 256 * j);
        }
        ss = wave_sum(ss);
        const float rstd = rsqrtf(ss * (1.0f / 1024.0f) + 1e-6f);
#pragma unroll
        for (int j = 0; j < 4; ++j) {
            const int c = lane * 4 + 256 * j;
            const f32x4 sc = *(const f32x4*)(modl + (size_t)b * 6144 + sc_off + c);
            const f32x4 sh = *(const f32x4*)(modl + (size_t)b * 6144 + sh_off + c);
            float o[4];
#pragma unroll
            for (int e = 0; e < 4; ++e) o[e] = v[j][e] * rstd * gg[j][e] * (1.0f + sc[e]) + sh[e];
            u32x2 pk; pk.x = pk2(o[0], o[1]); pk.y = pk2(o[2], o[3]);
            *(u32x2*)(dst + (size_t)row * 1024 + c) = pk;
        }
    }
}
__device__ __forceinline__ void final_norm_phase(float* x, const float* g) {
    const int tid = otid(), wid = __builtin_amdgcn_readfirstlane(tid >> 6), lane = tid & 63;
    const int stride = ogrid() * 8;
    int row = obid() * 8 + wid;
    if (row >= T_) return;
    f32x4 gg[4];
#pragma unroll
    for (int j = 0; j < 4; ++j) gg[j] = *(const f32x4*)(g + lane * 4 + 256 * j);
    f32x4 vn[4];
#pragma unroll
    for (int j = 0; j < 4; ++j) vn[j] = *(const f32x4*)(x + (size_t)row * 1024 + lane * 4 + 256 * j);
    for (; row < T_; row += stride) {
        float* xr = x + (size_t)row * 1024;
        f32x4 v[4]; float ss = 0.f;
#pragma unroll
        for (int j = 0; j < 4; ++j) { v[j] = vn[j]; ss += v[j][0] * v[j][0] + v[j][1] * v[j][1] + v[j][2] * v[j][2] + v[j][3] * v[j][3]; }
        if (row + stride < T_) {
#pragma unroll
            for (int j = 0; j < 4; ++j) vn[j] = *(const f32x4*)(x + (size_t)(row + stride) * 1024 + lane * 4 + 256 * j);
        }
        ss = wave_sum(ss);
        const float rstd = rsqrtf(ss * (1.0f / 1024.0f) + 1e-6f);
#pragma unroll
        for (int j = 0; j < 4; ++j) { const int c = lane * 4 + 256 * j; *(f32x4*)(xr + c) = v[j] * rstd * gg[j]; }
    }
}

__device__ __forceinline__ float raw_at(const bf16_t* proj, const bf16_t* halo, int b, int n, int r, int col) {
    if (r >= 0) return bf2f(proj[((size_t)(b * SEQ + n * 64 + r)) * PC + col]);
    if (n == 0) return 0.f;
    return bf2f(halo[((size_t)(b * 64 + n - 1) * 3 + (r + 3)) * CONVC + col]);
}

__device__ __forceinline__ void gdn_prep(const Params& p, int l, int b, int n, int h, float* sm) {
    bf16_t* proj = (bf16_t*)(p.ws + WS_PROJ); const bf16_t* halo = (const bf16_t*)(p.ws + WS_HALO);
    bf16_t* wbuf = (bf16_t*)(p.ws + WS_M); bf16_t* abuf = (bf16_t*)(p.ws + WS_M + 33554432);
    float* Gc = (float*)(p.ws + WS_GC);
    float* Qs = sm; float* Ks = sm + 8448; float* Vs = sm + 16896; float* Am = sm + 25344; float* At = sm + 29696; float* gb = sm + 34048; float* bt = sm + 34112;
    bf16_t* Rq = (bf16_t*)Am; bf16_t* Rk = (bf16_t*)At; bf16_t* Rv = (bf16_t*)(sm + 34176);
    const int tid = otid(), wid = __builtin_amdgcn_readfirstlane(tid >> 6), lane = tid & 63, fr = lane & 15, kg = lane >> 4;
    const size_t tok0 = (size_t)b * SEQ + n * 64;
    const float* cw = p.in[8] + (size_t)l * 4 * CONVC; const float* cbv = p.in[9] + (size_t)l * CONVC;
    {
        const int nm1 = n > 0 ? n - 1 : 0;
        u32x4 sv[7];
#pragma unroll
        for (int q = 0; q < 7; ++q) {
            int idx = tid + 512 * q; idx = idx < 3216 ? idx : 3215;
            const int row = idx / 48, rem = idx % 48, which = rem >> 4, pc = rem & 15, r = row - 3, col = which * 512 + h * 128 + pc * 8;
            const bf16_t* ptr = (r >= 0) ? proj + (tok0 + r) * PC + col : halo + ((size_t)(b * 64 + nm1) * 3 + (r + 3)) * CONVC + col;
            sv[q] = *(const u32x4*)ptr;
        }
#pragma unroll
        for (int q = 0; q < 7; ++q) {
            const int idx = tid + 512 * q;
            if (idx < 3216) {
                const int row = idx / 48, rem = idx % 48, which = rem >> 4, pc = rem & 15, r = row - 3;
                u32x4 v = sv[q];
                if (r < 0 && n == 0) v = (u32x4){0u, 0u, 0u, 0u};
                *(u32x4*)((which == 0 ? Rq : which == 1 ? Rk : Rv) + row * 128 + pc * 8) = v;
            }
        }
    }
    if (tid < 64) {
        const float braw = bf2f(proj[(tok0 + tid) * PC + OBG + h]), araw = bf2f(proj[(tok0 + tid) * PC + OAG + h]);
        bt[tid] = sigmoidf_(braw);
        gb[tid] = -__expf(p.in[20][l * 4 + h]) * softplusf_(araw + p.in[21][l * 4 + h]);
    }
    __syncthreads();
    if (wid == 7) gb[lane] = wave_incl_scan(gb[lane], lane);
    if (tid < 384) {
        const int which = tid >> 7, d = tid & 127, col = which * 512 + h * 128 + d;
        const bf16_t* R = (which == 0 ? Rq : which == 1 ? Rk : Rv) + d;
        float* O = (which == 0 ? Qs : which == 1 ? Ks : Vs) + d;
        const float w0 = cw[col], w1 = cw[CONVC + col], w2 = cw[2 * CONVC + col], w3 = cw[3 * CONVC + col], bb = cbv[col];
        float x0 = bf2f(R[0]), x1 = bf2f(R[128]), x2 = bf2f(R[256]);
#pragma unroll 8
        for (int r = 0; r < 64; ++r) {
            const float x3 = bf2f(R[(r + 3) * 128]);
            O[r * 132] = siluf_(bb + w0 * x0 + w1 * x1 + w2 * x2 + w3 * x3);
            x0 = x1; x1 = x2; x2 = x3;
        }
    }
    __syncthreads();
    {
        float q0[8], q1[8], k0[8], k1[8], sq[8], sk[8];
#pragma unroll
        for (int i = 0; i < 8; ++i) {
            const int r = wid * 8 + i;
            q0[i] = Qs[r * 132 + lane]; q1[i] = Qs[r * 132 + 64 + lane]; k0[i] = Ks[r * 132 + lane]; k1[i] = Ks[r * 132 + 64 + lane];
            sq[i] = q0[i] * q0[i] + q1[i] * q1[i]; sk[i] = k0[i] * k0[i] + k1[i] * k1[i];
        }
#pragma unroll
        for (int o = 32; o > 0; o >>= 1)
#pragma unroll
            for (int i = 0; i < 8; ++i) { sq[i] += __shfl_xor(sq[i], o); sk[i] += __shfl_xor(sk[i], o); }
#pragma unroll
        for (int i = 0; i < 8; ++i) {
            const int r = wid * 8 + i;
            const float fq_ = rsqrtf(sq[i] + 1e-6f) * 0.08838834764831845f, fk_ = rsqrtf(sk[i] + 1e-6f);
            Qs[r * 132 + lane] = q0[i] * fq_; Qs[r * 132 + 64 + lane] = q1[i] * fq_; Ks[r * 132 + lane] = k0[i] * fk_; Ks[r * 132 + 64 + lane] = k1[i] * fk_;
        }
    }
    if (tid < 64) Gc[(tok0 + tid) * 4 + h] = gb[tid];
    __syncthreads();
#pragma unroll
    for (int tt = 0; tt < 2; ++tt) {
        const int t = wid * 2 + tt, it = t >> 2, jt = t & 3;
        f32x4 kk = (f32x4){0.f, 0.f, 0.f, 0.f}, qk = (f32x4){0.f, 0.f, 0.f, 0.f};
        if (jt <= it) {
#pragma unroll
            for (int ks = 0; ks < 4; ++ks) {
                const float* ka = Ks + (16 * it + fr) * 132 + 32 * ks + 8 * kg; const float* qa = Qs + (16 * it + fr) * 132 + 32 * ks + 8 * kg; const float* kb = Ks + (16 * jt + fr) * 132 + 32 * ks + 8 * kg;
                const bf16x8 fa = pack8(*(const f32x4*)ka, *(const f32x4*)(ka + 4)), fqa = pack8(*(const f32x4*)qa, *(const f32x4*)(qa + 4)), fb = pack8(*(const f32x4*)kb, *(const f32x4*)(kb + 4));
                kk = __builtin_amdgcn_mfma_f32_16x16x32_bf16(fa, fb, kk, 0, 0, 0);
                qk = __builtin_amdgcn_mfma_f32_16x16x32_bf16(fqa, fb, qk, 0, 0, 0);
            }
        }
        const int j = 16 * jt + fr; const float gj = gb[j];
#pragma unroll
        for (int r = 0; r < 4; ++r) {
            const int i = 16 * it + 4 * kg + r;
            const float dec = (j <= i) ? __expf(gb[i] - gj) : 0.f;
            Am[i * 68 + j] = (j < i) ? bt[i] * kk[r] * dec : 0.f;
            At[i * 68 + j] = qk[r] * dec;
        }
    }
    __syncthreads();
    {
        const float glast = gb[63];
#pragma unroll
        for (int q = 0; q < 2; ++q) {
            const int idx = tid + 512 * q;
            {
                const int i = idx >> 4, pq = idx & 15; const float eg = __expf(gb[i]);
                float v[8];
#pragma unroll
                for (int e = 0; e < 8; ++e) v[e] = Qs[i * 132 + iperm(pq * 8 + e)] * eg;
                u32x4 pk; pk.x = pk2(v[0], v[1]); pk.y = pk2(v[2], v[3]); pk.z = pk2(v[4], v[5]); pk.w = pk2(v[6], v[7]);
                *(u32x4*)(proj + (tok0 + i) * PC + OQ + h * 128 + pq * 8) = pk;
            }
            {
                const int d = idx & 127, pq = idx >> 7;
                float v[8];
#pragma unroll
                for (int e = 0; e < 8; ++e) { const int c = iperm(pq * 8 + e); v[e] = Ks[c * 132 + d] * __expf(glast - gb[c]); }
                u32x4 pk; pk.x = pk2(v[0], v[1]); pk.y = pk2(v[2], v[3]); pk.z = pk2(v[4], v[5]); pk.w = pk2(v[6], v[7]);
                *(u32x4*)(proj + (tok0 + (d >> 1)) * PC + OKK + h * 128 + (d & 1) * 64 + pq * 8) = pk;
            }
        }
        {
            const int i = tid >> 3, pq = tid & 7;
            float v[8];
#pragma unroll
            for (int e = 0; e < 8; ++e) v[e] = At[i * 68 + iperm(pq * 8 + e)];
            u32x4 pk; pk.x = pk2(v[0], v[1]); pk.y = pk2(v[2], v[3]); pk.z = pk2(v[4], v[5]); pk.w = pk2(v[6], v[7]);
            *(u32x4*)(abuf + (tok0 + i) * 256 + h * 64 + pq * 8) = pk;
        }
    }
    __syncthreads();
    for (int idx = tid; idx < 64 * 128; idx += 512) {
        const int i = idx >> 7, d = idx & 127;
        Ks[i * 132 + d] *= bt[i] * __expf(gb[i]);
        Vs[i * 132 + d] *= bt[i];
    }
    __syncthreads();
    if (tid < 256) {
        const int which = tid >> 7, d = tid & 127;
        float* rhs = (which == 0 ? Ks : Vs) + d;
        float s[64];
#pragma unroll
        for (int i = 0; i < 64; ++i) {
            float a = rhs[i * 132];
#pragma unroll
            for (int j4 = 0; j4 < (i + 3) / 4; ++j4) {
                const f32x4 av = *(const f32x4*)(Am + i * 68 + j4 * 4);
#pragma unroll
                for (int e = 0; e < 4; ++e) if (j4 * 4 + e < i) a -= av[e] * s[j4 * 4 + e];
            }
            s[i] = a;
        }
        if (which == 0) {
#pragma unroll
            for (int i = 0; i < 64; ++i) rhs[i * 132] = s[i];
        } else {
            bf16_t* up = proj + (tok0 + (d >> 1)) * PC + OV + h * 128 + (d & 1) * 64;
#pragma unroll
            for (int q = 0; q < 8; ++q) { u32x4 pk; pk.x = pk2(s[q * 8], s[q * 8 + 1]); pk.y = pk2(s[q * 8 + 2], s[q * 8 + 3]); pk.z = pk2(s[q * 8 + 4], s[q * 8 + 5]); pk.w = pk2(s[q * 8 + 6], s[q * 8 + 7]); *(u32x4*)(up + q * 8) = pk; }
        }
    }
    __syncthreads();
#pragma unroll
    for (int q = 0; q < 2; ++q) {
        const int idx = tid + 512 * q, i = idx >> 4, pq = idx & 15;
        float v[8];
#pragma unroll
        for (int e = 0; e < 8; ++e) v[e] = Ks[i * 132 + iperm(pq * 8 + e)];
        u32x4 pk; pk.x = pk2(v[0], v[1]); pk.y = pk2(v[2], v[3]); pk.z = pk2(v[4], v[5]); pk.w = pk2(v[6], v[7]);
        *(u32x4*)(wbuf + (tok0 + i) * 512 + h * 128 + pq * 8) = pk;
    }
    __syncthreads();
}

__device__ __forceinline__ void ssd_prep(const Params& p, int l, int b, int n, float* sm) {
    bf16_t* proj = (bf16_t*)(p.ws + WS_PROJ); const bf16_t* halo = (const bf16_t*)(p.ws + WS_HALO);
    bf16_t* cbbuf = (bf16_t*)(p.ws + WS_M + 50331648);
    float* dtb = (float*)(p.ws + WS_DT); float* csb = (float*)(p.ws + WS_CS);
    const int tid = otid();
    const size_t tok0 = (size_t)b * SEQ + n * 64;
    const float* cw = p.in[8] + (size_t)l * 4 * CONVC; const float* cbv = p.in[9] + (size_t)l * CONVC;
    bf16_t* Lt = (bf16_t*)sm;
    float* la = sm + 26000;
    {
        const int nm1 = n > 0 ? n - 1 : 0;
        u32x4 sv[13];
#pragma unroll
        for (int q = 0; q < 13; ++q) {
            int idx = tid + 512 * q; idx = idx < 6432 ? idx : 6431;
            const int row = idx / 96, pc = idx % 96, r = row - 3, col = OXS + pc * 8;
            const bf16_t* ptr = (r >= 0) ? proj + (tok0 + r) * PC + col : halo + ((size_t)(b * 64 + nm1) * 3 + (r + 3)) * CONVC + col;
            sv[q] = *(const u32x4*)ptr;
        }
#pragma unroll
        for (int q = 0; q < 13; ++q) {
            const int idx = tid + 512 * q;
            if (idx < 6432) {
                const int row = idx / 96, pc = idx % 96, r = row - 3;
                u32x4 v = sv[q];
                if (r < 0 && n == 0) v = (u32x4){0u, 0u, 0u, 0u};
                *(u32x4*)(Lt + row * 776 + pc * 8) = v;
            }
        }
    }
    __syncthreads();
    for (int c = tid; c < 768; c += 512) {
        const int col = OXS + c;
        const float w0 = cw[col], w1 = cw[CONVC + col], w2 = cw[2 * CONVC + col], w3 = cw[3 * CONVC + col], bb = cbv[col];
        float x0 = bf2f(Lt[c]), x1 = bf2f(Lt[776 + c]), x2 = bf2f(Lt[2 * 776 + c]);
#pragma unroll 8
        for (int r = 0; r < 64; ++r) {
            const float x3 = bf2f(Lt[(r + 3) * 776 + c]);
            Lt[r * 776 + c] = f2bf(siluf_(bb + w0 * x0 + w1 * x1 + w2 * x2 + w3 * x3));
            x0 = x1; x1 = x2; x2 = x3;
        }
    }
    {
        const int r = tid >> 3, j = tid & 7;
        const float dt = softplusf_(bf2f(proj[(tok0 + r) * PC + ODT + j]) + p.in[24][l * 8 + j]);
        dtb[(tok0 + r) * 8 + j] = dt;
        la[r * 8 + j] = -__expf(p.in[23][l * 8 + j]) * dt;
    }
    __syncthreads();
    { const int wv = __builtin_amdgcn_readfirstlane(tid >> 6), ln = tid & 63; csb[(tok0 + ln) * 8 + wv] = wave_incl_scan(la[ln * 8 + wv], ln); }
    {
        bf16_t* dst = proj + (tok0 + (tid & 63)) * PC + OXS + (tid >> 6) * 64;
#pragma unroll
        for (int q = 0; q < 8; ++q) {
            u32x4 pk;
            pk.x = (unsigned)Lt[(q * 8 + 0) * 776 + tid] | ((unsigned)Lt[(q * 8 + 1) * 776 + tid] << 16); pk.y = (unsigned)Lt[(q * 8 + 2) * 776 + tid] | ((unsigned)Lt[(q * 8 + 3) * 776 + tid] << 16);
            pk.z = (unsigned)Lt[(q * 8 + 4) * 776 + tid] | ((unsigned)Lt[(q * 8 + 5) * 776 + tid] << 16); pk.w = (unsigned)Lt[(q * 8 + 6) * 776 + tid] | ((unsigned)Lt[(q * 8 + 7) * 776 + tid] << 16);
            *(u32x4*)(dst + q * 8) = pk;
        }
    }
    if (tid < 128) {
        bf16_t* dst = proj + (tok0 + (tid & 63)) * PC + OBS + (tid >> 6) * 64;
        const int c = 512 + tid;
#pragma unroll
        for (int q = 0; q < 8; ++q) {
            u32x4 pk;
            pk.x = (unsigned)Lt[(q * 8 + 0) * 776 + c] | ((unsigned)Lt[(q * 8 + 1) * 776 + c] << 16); pk.y = (unsigned)Lt[(q * 8 + 2) * 776 + c] | ((unsigned)Lt[(q * 8 + 3) * 776 + c] << 16);
            pk.z = (unsigned)Lt[(q * 8 + 4) * 776 + c] | ((unsigned)Lt[(q * 8 + 5) * 776 + c] << 16); pk.w = (unsigned)Lt[(q * 8 + 6) * 776 + c] | ((unsigned)Lt[(q * 8 + 7) * 776 + c] << 16);
            *(u32x4*)(dst + q * 8) = pk;
        }
    } else if (tid < 256) {
        const int lrow = tid & 63, g = (tid >> 6) & 1;
        bf16_t* dst = proj + (tok0 + lrow) * PC + OCS + g * 64;
        const bf16_t* src = Lt + lrow * 776 + 640 + g * 64;
#pragma unroll
        for (int q = 0; q < 8; ++q) {
            u32x4 pk;
            pk.x = (unsigned)src[iperm(q * 8 + 0)] | ((unsigned)src[iperm(q * 8 + 1)] << 16); pk.y = (unsigned)src[iperm(q * 8 + 2)] | ((unsigned)src[iperm(q * 8 + 3)] << 16);
            pk.z = (unsigned)src[iperm(q * 8 + 4)] | ((unsigned)src[iperm(q * 8 + 5)] << 16); pk.w = (unsigned)src[iperm(q * 8 + 6)] | ((unsigned)src[iperm(q * 8 + 7)] << 16);
            *(u32x4*)(dst + q * 8) = pk;
        }
    }
    {
        const int lrow = tid >> 3, mg = tid & 7;
#pragma unroll 1
        for (int g = 0; g < 2; ++g) {
            float cb[8];
#pragma unroll
            for (int mm = 0; mm < 8; ++mm) cb[mm] = 0.f;
            const bf16_t* cp = Lt + lrow * 776 + 640 + g * 64;
#pragma unroll 4
            for (int q = 0; q < 64; q += 2) {
                const unsigned cu = *(const unsigned*)(cp + q);
                const float c0 = __uint_as_float(cu << 16), c1 = __uint_as_float(cu & 0xffff0000u);
#pragma unroll
                for (int mm = 0; mm < 8; ++mm) { const unsigned bu = *(const unsigned*)(Lt + (mg + 8 * mm) * 776 + 512 + g * 64 + q); cb[mm] += c0 * __uint_as_float(bu << 16) + c1 * __uint_as_float(bu & 0xffff0000u); }
            }
#pragma unroll
            for (int mm = 0; mm < 8; ++mm) cbbuf[(tok0 + lrow) * 128 + g * 64 + mg + 8 * mm] = f2bf(cb[mm]);
        }
    }
    __syncthreads();
}

template <int MODE>
__device__ __forceinline__ void lru_chunk(const Params& p, int l, int b, int n, float* sm) {
    bf16_t* proj = (bf16_t*)(p.ws + WS_PROJ); const bf16_t* halo = (const bf16_t*)(p.ws + WS_HALO);
    float* LA = (float*)(p.ws + WS_LA); float* LH = (float*)(p.ws + WS_LH);
    const bf16_t* Wt = (const bf16_t*)(p.ws + WS_PAR + 294912);
    const int tid = otid(), wid = __builtin_amdgcn_readfirstlane(tid >> 6), lane = tid & 63, fr = lane & 15, kg = lane >> 4;
    const int nb = wid, ch = nb * 64 + lane, col = OXL + ch;
    unsigned char* wbase = (unsigned char*)sm + wid * 18432;
    bf16_t* xb = (bf16_t*)wbase;
    float* pre = (float*)(wbase + 9728);
    const size_t tok0 = (size_t)b * SEQ + n * 64;
    const float* cw = p.in[8] + (size_t)l * 4 * CONVC; const float* cbv = p.in[9] + (size_t)l * CONVC;
    {
        const int nm1 = n > 0 ? n - 1 : 0;
        u32x4 sv[9];
#pragma unroll
        for (int q = 0; q < 9; ++q) {
            int idx = lane + 64 * q; idx = idx < 536 ? idx : 535;
            const int row = idx >> 3, pc = idx & 7, r = row - 3, c8 = OXL + nb * 64 + pc * 8;
            const bf16_t* ptr = (r >= 0) ? proj + (tok0 + r) * PC + c8 : halo + ((size_t)(b * 64 + nm1) * 3 + (r + 3)) * CONVC + c8;
            sv[q] = *(const u32x4*)ptr;
        }
#pragma unroll
        for (int q = 0; q < 9; ++q) {
            const int idx = lane + 64 * q;
            if (idx < 536) {
                const int row = idx >> 3, pc = idx & 7, r = row - 3;
                u32x4 v = sv[q];
                if (r < 0 && n == 0) v = (u32x4){0u, 0u, 0u, 0u};
                *(u32x4*)(xb + row * 72 + pc * 8) = v;
            }
        }
    }
    bf16x8 Wf[2][4][2];
#pragma unroll
    for (int gs = 0; gs < 2; ++gs)
#pragma unroll
        for (int et = 0; et < 4; ++et)
#pragma unroll
            for (int ks = 0; ks < 2; ++ks) Wf[gs][et][ks] = *(const bf16x8*)(Wt + ((size_t)((gs * 8 + nb) * 64 + 16 * et + fr)) * 64 + 32 * ks + 8 * kg);
    asm volatile("s_waitcnt lgkmcnt(0)" ::: "memory");
    {
        const float w0 = cw[col], w1 = cw[CONVC + col], w2 = cw[2 * CONVC + col], w3 = cw[3 * CONVC + col], bb = cbv[col];
        float x0 = bf2f(xb[lane]), x1 = bf2f(xb[72 + lane]), x2 = bf2f(xb[144 + lane]);
#pragma unroll 8
        for (int r = 0; r < 64; ++r) {
            const float x3 = bf2f(xb[(r + 3) * 72 + lane]);
            xb[r * 72 + lane] = f2bf(bb + w0 * x0 + w1 * x1 + w2 * x2 + w3 * x3);
            x0 = x1; x1 = x2; x2 = x3;
        }
    }
    asm volatile("s_waitcnt lgkmcnt(0)" ::: "memory");
    const float sp = 8.0f * softplusf_(-p.in[27][l * 512 + ch]);
    const float br_ = p.in[29][l * 512 + ch], bi_ = p.in[31][l * 512 + ch];
    const size_t ci = ((size_t)b * 64 + n) * 512 + ch;
    float H = (MODE == 1) ? LH[ci] : 0.f, A = 1.f;
#pragma unroll 1
    for (int q = 0; q < 4; ++q) {
        bf16x8 af[2];
#pragma unroll
        for (int ks = 0; ks < 2; ++ks) af[ks] = *(const bf16x8*)(xb + (16 * q + fr) * 72 + 32 * ks + 8 * kg);
#pragma unroll
        for (int gs = 0; gs < 2; ++gs)
#pragma unroll
            for (int et = 0; et < 4; ++et) {
                f32x4 acc = (f32x4){0.f, 0.f, 0.f, 0.f};
                acc = __builtin_amdgcn_mfma_f32_16x16x32_bf16(af[0], Wf[gs][et][0], acc, 0, 0, 0);
                acc = __builtin_amdgcn_mfma_f32_16x16x32_bf16(af[1], Wf[gs][et][1], acc, 0, 0, 0);
#pragma unroll
                for (int r = 0; r < 4; ++r) pre[(4 * kg + r) * 132 + gs * 64 + 16 * et + fr] = acc[r];
            }
        asm volatile("s_waitcnt lgkmcnt(0)" ::: "memory");
#pragma unroll 4
        for (int t = 0; t < 16; ++t) {
            const int r = 16 * q + t;
            const float rg = sigmoidf_(pre[t * 132 + lane] + br_), ig = sigmoidf_(pre[t * 132 + 64 + lane] + bi_);
            const float log_a = -sp * rg;
            const float a = __expf(log_a);
            float mult = __builtin_amdgcn_sqrtf(fmaxf(1.0f - a * a, 0.f));
            if (n == 0 && r == 0) mult = 1.0f;
            H = a * H + mult * ig * bf2f(xb[r * 72 + lane]);
            if (MODE == 0) A *= a;
            else {
                const float gt = bf2f(proj[(tok0 + r) * PC + OGL + ch]);
                proj[(tok0 + r) * PC + col] = f2bf(H * geluf_(gt));
            }
        }
        asm volatile("s_waitcnt lgkmcnt(0)" ::: "memory");
    }
    if (MODE == 0) { LA[ci] = A; LH[ci] = H; }
    __syncthreads();
}

__device__ __forceinline__ void s5_consts(const Params& p, int l, int g, int pp, float& lr, float& li, float (&Br)[16], float (&Bi)[16]) {
    const int gp = (l * 24 + g) * 64 + pp;
    const float re = p.in[10][gp], im = p.in[11][gp], dt = __expf(p.in[12][l * 24 + g]);
    const float a = re * dt, th = im * dt;
    const float ea = __expf(a), cs = cosf(th), sn = sinf(th);
    lr = ea * cs; li = ea * sn;
    const float sh = sinf(0.5f * th);
    const float mr = expm1f(a) * cs - 2.0f * sh * sh, mi = li;
    const float den = 1.0f / (re * re + im * im);
    const float fr_ = (mr * re + mi * im) * den, fi_ = (mi * re - mr * im) * den;
#pragma unroll
    for (int h = 0; h < 16; ++h) {
        const float br = p.in[13][(size_t)gp * 16 + h], bi = p.in[14][(size_t)gp * 16 + h];
        Br[h] = fr_ * br - fi_ * bi; Bi[h] = fr_ * bi + fi_ * br;
    }
}
template <int MODE>
__device__ __forceinline__ void s5_chunk(const Params& p, int l, int b, int n, float* sm) {
    bf16_t* proj = (bf16_t*)(p.ws + WS_PROJ);
    float* S5C = (float*)(p.ws + WS_S5C);
    const bf16_t* gluT = (const bf16_t*)(p.ws + WS_PAR);
    float* us = sm;
    const int tid = otid(), wid = __builtin_amdgcn_readfirstlane(tid >> 6), lane = tid & 63, fr = lane & 15, kg = lane >> 4;
    bf16_t* xw = (bf16_t*)(sm + 24832) + wid * 2048;
    const size_t tok0 = (size_t)b * SEQ + n * 64;
#pragma unroll
    for (int q = 0; q < 6; ++q) {
        const int idx = tid + 512 * q, r = idx / 48, pc = idx % 48;
        const u32x4 v = *(const u32x4*)(proj + (tok0 + r) * PC + OU5 + pc * 8);
        *(f32x4*)(us + r * 388 + pc * 8) = up4((u32x2){v.x, v.y}); *(f32x4*)(us + r * 388 + pc * 8 + 4) = up4((u32x2){v.z, v.w});
    }
    __syncthreads();
    for (int g = wid; g < 24; g += 8) {
        float lr, li, Br[16], Bi[16];
        s5_consts(p, l, g, lane, lr, li, Br, Bi);
        f32x2 B2[16];
#pragma unroll
        for (int h = 0; h < 16; ++h) { B2[h].x = Br[h]; B2[h].y = Bi[h]; }
        float Xr = 0.f, Xi = 0.f;
        const size_t cidx = ((((size_t)b * 64 + n) * 24 + g) * 64 + lane) * 2;
        bf16x8 Cf[4];
        if (MODE == 1) {
            Xr = S5C[cidx]; Xi = S5C[cidx + 1];
            const float* crp = p.in[15] + ((size_t)(l * 24 + g) * 16 + fr) * 64; const float* cip = p.in[16] + ((size_t)(l * 24 + g) * 16 + fr) * 64;
#pragma unroll
            for (int ks = 0; ks < 4; ++ks) {
                const f32x4 cr = *(const f32x4*)(crp + 16 * ks + 4 * kg), ci = *(const f32x4*)(cip + 16 * ks + 4 * kg);
                Cf[ks] = pack8((f32x4){cr[0], -ci[0], cr[1], -ci[1]}, (f32x4){cr[2], -ci[2], cr[3], -ci[3]});
            }
        }
#pragma unroll 1
        for (int sb = 0; sb < 4; ++sb) {
#pragma unroll 4
            for (int ss = 0; ss < 16; ++ss) {
                const int s = sb * 16 + ss;
                f32x2 bu = {0.f, 0.f};
#pragma unroll
                for (int h4 = 0; h4 < 4; ++h4) {
                    const f32x4 u = *(const f32x4*)(us + s * 388 + g * 16 + h4 * 4);
                    bu += B2[h4 * 4 + 0] * u[0]; bu += B2[h4 * 4 + 1] * u[1]; bu += B2[h4 * 4 + 2] * u[2]; bu += B2[h4 * 4 + 3] * u[3];
                }
                const float nr = lr * Xr - li * Xi + bu.x, ni = lr * Xi + li * Xr + bu.y;
                Xr = nr; Xi = ni;
                if (MODE == 1) *(unsigned*)(xw + ss * 128 + 2 * lane) = pk2(Xr, Xi);
            }
            if (MODE == 1) {
                asm volatile("s_waitcnt lgkmcnt(0)" ::: "memory");
                f32x4 acc = (f32x4){0.f, 0.f, 0.f, 0.f};
                bf16x8 af[4];
#pragma unroll
                for (int ks = 0; ks < 4; ++ks) af[ks] = *(const bf16x8*)(xw + fr * 128 + 32 * ks + 8 * kg);
                asm volatile("s_waitcnt lgkmcnt(0)" ::: "memory");
#pragma unroll
                for (int ks = 0; ks < 4; ++ks) acc = __builtin_amdgcn_mfma_f32_16x16x32_bf16(af[ks], Cf[ks], acc, 0, 0, 0);
                const int c = g * 16 + fr; const float dd = p.in[17][l * 384 + c];
#pragma unroll
                for (int r = 0; r < 4; ++r) { const int s = sb * 16 + 4 * kg + r; us[s * 388 + c] = geluf_(acc[r] + dd * us[s * 388 + c]); }
            }
        }
        if (MODE == 0) { S5C[cidx] = Xr; S5C[cidx + 1] = Xi; }
    }
    __syncthreads();
    if (MODE == 1) {
        f32x4 acc[3][4];
#pragma unroll
        for (int a = 0; a < 3; ++a)
#pragma unroll
            for (int m = 0; m < 4; ++m) acc[a][m] = (f32x4){0.f, 0.f, 0.f, 0.f};
#pragma unroll 1
        for (int ks = 0; ks < 12; ++ks) {
            bf16x8 af[4];
#pragma unroll
            for (int m = 0; m < 4; ++m) { const float* ap = us + (16 * m + fr) * 388 + 32 * ks + 8 * kg; af[m] = pack8(*(const f32x4*)ap, *(const f32x4*)(ap + 4)); }
#pragma unroll
            for (int a = 0; a < 3; ++a) {
                const bf16x8 bfr = *(const bf16x8*)(gluT + (size_t)(16 * (wid * 3 + a) + fr) * 384 + 32 * ks + 8 * kg);
#pragma unroll
                for (int m = 0; m < 4; ++m) acc[a][m] = __builtin_amdgcn_mfma_f32_16x16x32_bf16(af[m], bfr, acc[a][m], 0, 0, 0);
            }
        }
        __syncthreads();
#pragma unroll
        for (int a = 0; a < 3; ++a) {
            const int j = 16 * (wid * 3 + a) + fr; const float gbias = p.in[19][l * 384 + j];
#pragma unroll
            for (int m = 0; m < 4; ++m)
#pragma unroll
                for (int r = 0; r < 4; ++r) { const int s = 16 * m + 4 * kg + r; us[s * 388 + j] *= sigmoidf_(acc[a][m][r] + gbias); }
        }
        __syncthreads();
#pragma unroll
        for (int q = 0; q < 6; ++q) {
            const int idx = tid + 512 * q, r = idx / 48, pc = idx % 48;
            const f32x4 a = *(const f32x4*)(us + r * 388 + pc * 8), c = *(const f32x4*)(us + r * 388 + pc * 8 + 4);
            u32x4 pk; pk.x = pk2(a[0], a[1]); pk.y = pk2(a[2], a[3]); pk.z = pk2(c[0], c[1]); pk.w = pk2(c[2], c[3]);
            *(u32x4*)(proj + (tok0 + r) * PC + OU5 + pc * 8) = pk;
        }
        __syncthreads();
    }
}

#define MFMA16(a, b, c) __builtin_amdgcn_mfma_f32_16x16x32_bf16((a), (b), (c), 0, 0, 0)
__device__ __forceinline__ void gdn_seq(const Params& p, int b, int h, int half, float* sm) {
    bf16_t* proj = (bf16_t*)(p.ws + WS_PROJ);
    const bf16_t* wbuf = (const bf16_t*)(p.ws + WS_M); const bf16_t* abuf = (const bf16_t*)(p.ws + WS_M + 33554432);
    const float* Gc = (const float*)(p.ws + WS_GC);
    unsigned char* L = (unsigned char*)sm;
    constexpr int OW = 0, OQL = 17408, OA = 34816, OKT = 44032, BUF = 62464;
    const int tid = otid(), wid = __builtin_amdgcn_readfirstlane(tid >> 6), lane = tid & 63, fr = lane & 15, kg = lane >> 4;
    const int e = (half * 4 + (wid & 3)) * 16 + fr;
    const bool cw_ = wid < 4;
    const size_t tokb = (size_t)b * SEQ;
    const int r16 = tid >> 4, pc16 = tid & 15, r8 = tid >> 3, pc8 = tid & 7;
    u32x4 gW[2], gQ[2], gA, gK[2]; u32x2 gU[4];
    auto issue = [&](int n) {
        const size_t tok0 = tokb + (size_t)n * 64;
#pragma unroll
        for (int q = 0; q < 2; ++q) {
            const int row = r16 + 32 * q;
            gW[q] = *(const u32x4*)(wbuf + (tok0 + row) * 512 + h * 128 + pc16 * 8);
            gQ[q] = *(const u32x4*)(proj + (tok0 + row) * PC + OQ + h * 128 + pc16 * 8);
            gK[q] = *(const u32x4*)(proj + (tok0 + row) * PC + OKK + h * 128 + pc16 * 8);
        }
        gA = *(const u32x4*)(abuf + (tok0 + r8) * 256 + h * 64 + pc8 * 8);
#pragma unroll
        for (int ct = 0; ct < 4; ++ct) gU[ct] = *(const u32x2*)(proj + (tok0 + (e >> 1)) * PC + OV + h * 128 + (e & 1) * 64 + 16 * ct + 4 * kg);
    };
    auto commit = [&](int buf) {
        unsigned char* B = L + buf * BUF;
#pragma unroll
        for (int q = 0; q < 2; ++q) {
            const int row = r16 + 32 * q;
            *(u32x4*)(B + OW + row * 272 + pc16 * 16) = gW[q];
            *(u32x4*)(B + OQL + row * 272 + pc16 * 16) = gQ[q];
            *(u32x4*)(B + OKT + (2 * row + (pc16 >> 3)) * 144 + (pc16 & 7) * 16) = gK[q];
        }
        *(u32x4*)(B + OA + r8 * 144 + pc8 * 16) = gA;
    };
    f32x4 S[8];
#pragma unroll
    for (int i = 0; i < 8; ++i) S[i] = (f32x4){0.f, 0.f, 0.f, 0.f};
    issue(0); commit(0);
    f32x4 U[4];
#pragma unroll
    for (int ct = 0; ct < 4; ++ct) U[ct] = up4(gU[ct]);
    __syncthreads();
#pragma unroll 1
    for (int n = 0; n < 64; ++n) {
        const unsigned char* B = L + (n & 1) * BUF;
        const size_t tok0 = tokb + (size_t)n * 64;
        if (n + 1 < 64) issue(n + 1);
        if (cw_) {
        const float gl = __expf(Gc[(tok0 + 63) * 4 + h]);
        bf16x8 Sf[4];
#pragma unroll
        for (int s4 = 0; s4 < 4; ++s4) Sf[s4] = pack8(S[2 * s4], S[2 * s4 + 1]);
        f32x4 V[4], O[4];
#pragma unroll
        for (int ct = 0; ct < 4; ++ct) {
            f32x4 t = (f32x4){0.f, 0.f, 0.f, 0.f}, o = (f32x4){0.f, 0.f, 0.f, 0.f};
#pragma unroll
            for (int s4 = 0; s4 < 4; ++s4) {
                const bf16x8 wf = *(const bf16x8*)(B + OW + (16 * ct + fr) * 272 + (32 * s4 + 8 * kg) * 2);
                const bf16x8 qf = *(const bf16x8*)(B + OQL + (16 * ct + fr) * 272 + (32 * s4 + 8 * kg) * 2);
                t = MFMA16(wf, Sf[s4], t); o = MFMA16(qf, Sf[s4], o);
            }
            V[ct] = U[ct] - t; O[ct] = o;
        }
        bf16x8 Vf[2];
        Vf[0] = pack8(V[0], V[1]); Vf[1] = pack8(V[2], V[3]);
#pragma unroll
        for (int ct = 0; ct < 4; ++ct) {
#pragma unroll
            for (int s2 = 0; s2 < 2; ++s2) {
                const bf16x8 af = *(const bf16x8*)(B + OA + (16 * ct + fr) * 144 + (32 * s2 + 8 * kg) * 2);
                O[ct] = MFMA16(af, Vf[s2], O[ct]);
            }
            u32x2 pk; pk.x = pk2(O[ct][0], O[ct][1]); pk.y = pk2(O[ct][2], O[ct][3]);
            *(u32x2*)(proj + (tok0 + (e >> 1)) * PC + OV + h * 128 + (e & 1) * 64 + 16 * ct + 4 * kg) = pk;
        }
#pragma unroll
        for (int dt = 0; dt < 8; ++dt) {
            f32x4 a = S[dt] * gl;
#pragma unroll
            for (int s2 = 0; s2 < 2; ++s2) {
                const bf16x8 kf = *(const bf16x8*)(B + OKT + (16 * dt + fr) * 144 + (32 * s2 + 8 * kg) * 2);
                a = MFMA16(kf, Vf[s2], a);
            }
            S[dt] = a;
        }
        }
        if (n + 1 < 64) {
            commit((n + 1) & 1);
#pragma unroll
            for (int ct = 0; ct < 4; ++ct) U[ct] = up4(gU[ct]);
        }
        __syncthreads();
    }
}

__device__ __forceinline__ void ssd_seq(const Params& p, int l, int b, int j, float* sm) {
    bf16_t* proj = (bf16_t*)(p.ws + WS_PROJ);
    const bf16_t* cbbuf = (const bf16_t*)(p.ws + WS_M + 50331648);
    const float* dtb = (const float*)(p.ws + WS_DT); const float* csb = (const float*)(p.ws + WS_CS);
    unsigned char* L = (unsigned char*)sm;
    constexpr int OCB = 0, OC = 9216, OBT = 18432, ODTL = 27648, OCSL = 27904, BUF = 28160;
    const int tid = otid(), wid = __builtin_amdgcn_readfirstlane(tid >> 6), lane = tid & 63, fr = lane & 15, kg = lane >> 4, g = j >> 2;
    const float dsk = p.in[25][l * 8 + j];
    const size_t tokb = (size_t)b * SEQ;
    const int r8 = tid >> 3, pc8 = tid & 7;
    const int pch = (wid & 3) * 16 + fr;
    u32x4 gCB, gC, gBT, gX[2]; u32x2 gXs[4]; float gv = 0.f;
    auto issue = [&](int n) {
        const size_t tok0 = tokb + (size_t)n * 64;
        gCB = *(const u32x4*)(cbbuf + (tok0 + r8) * 128 + g * 64 + pc8 * 8);
        gC = *(const u32x4*)(proj + (tok0 + r8) * PC + OCS + g * 64 + pc8 * 8);
        gBT = *(const u32x4*)(proj + (tok0 + r8) * PC + OBS + g * 64 + pc8 * 8);
        if (tid < 64) gv = dtb[(tok0 + tid) * 8 + j]; else if (tid < 128) gv = csb[(tok0 + tid - 64) * 8 + j];
        if (wid < 4) {
            const bf16_t* xp = proj + (tok0 + pch) * PC + OXS + j * 64;
#pragma unroll
            for (int s2 = 0; s2 < 2; ++s2) gX[s2] = *(const u32x4*)(xp + 32 * s2 + 8 * kg);
#pragma unroll
            for (int lt = 0; lt < 4; ++lt) gXs[lt] = *(const u32x2*)(xp + 16 * lt + 4 * kg);
        }
    };
    auto commit = [&](int buf) {
        unsigned char* B = L + buf * BUF;
        *(u32x4*)(B + OCB + r8 * 144 + pc8 * 16) = gCB;
        *(u32x4*)(B + OC + r8 * 144 + pc8 * 16) = gC;
        *(u32x4*)(B + OBT + r8 * 144 + pc8 * 16) = gBT;
        if (tid < 64) *(float*)(B + ODTL + tid * 4) = gv; else if (tid < 128) *(float*)(B + OCSL + (tid - 64) * 4) = gv;
    };
    f32x4 St[4];
#pragma unroll
    for (int i = 0; i < 4; ++i) St[i] = (f32x4){0.f, 0.f, 0.f, 0.f};
    issue(0); commit(0);
    u32x4 cX[2]; u32x2 cXs[4];
#pragma unroll
    for (int i = 0; i < 2; ++i) cX[i] = gX[i];
#pragma unroll
    for (int i = 0; i < 4; ++i) cXs[i] = gXs[i];
    __syncthreads();
#pragma unroll 1
    for (int n = 0; n < 64; ++n) {
        const unsigned char* B = L + (n & 1) * BUF;
        const size_t tok0 = tokb + (size_t)n * 64;
        if (n + 1 < 64) issue(n + 1);
        if (wid < 4) {
            const float* dtl = (const float*)(B + ODTL); const float* csl = (const float*)(B + OCSL);
            const float cend = csl[63];
            bf16x8 Xd[2], Xf[2];
#pragma unroll
            for (int s2 = 0; s2 < 2; ++s2) {
                const f32x4 xa = up4((u32x2){cX[s2].x, cX[s2].y}), xb = up4((u32x2){cX[s2].z, cX[s2].w});
                f32x4 da, db, fa, fb;
#pragma unroll
                for (int i = 0; i < 4; ++i) {
                    const int m0 = 32 * s2 + 8 * kg + i, m1 = m0 + 4;
                    da[i] = xa[i] * dtl[m0]; db[i] = xb[i] * dtl[m1];
                    fa[i] = da[i] * __expf(cend - csl[m0]); fb[i] = db[i] * __expf(cend - csl[m1]);
                }
                Xd[s2] = pack8(da, db); Xf[s2] = pack8(fa, fb);
            }
            bf16x8 Sb[2];
            Sb[0] = pack8(St[0], St[1]); Sb[1] = pack8(St[2], St[3]);
#pragma unroll
            for (int lt = 0; lt < 4; ++lt) {
                f32x4 y = (f32x4){0.f, 0.f, 0.f, 0.f};
#pragma unroll
                for (int s2 = 0; s2 < 2; ++s2) { const bf16x8 cf = *(const bf16x8*)(B + OC + (16 * lt + fr) * 144 + (32 * s2 + 8 * kg) * 2); y = MFMA16(cf, Sb[s2], y); }
#pragma unroll
                for (int r = 0; r < 4; ++r) y[r] *= __expf(csl[16 * lt + 4 * kg + r]);
                const int lrow = 16 * lt + fr; const float cl_ = csl[lrow];
#pragma unroll
                for (int s2 = 0; s2 < 2; ++s2) {
                    if (32 * s2 <= 16 * lt + 15) {
                        const u32x4 raw = *(const u32x4*)(B + OCB + lrow * 144 + (32 * s2 + 8 * kg) * 2);
                        const f32x4 ca = up4((u32x2){raw.x, raw.y}), cb = up4((u32x2){raw.z, raw.w});
                        f32x4 ea, eb;
#pragma unroll
                        for (int i = 0; i < 4; ++i) {
                            const int m0 = 32 * s2 + 8 * kg + i, m1 = m0 + 4;
                            ea[i] = (m0 <= lrow) ? ca[i] * __expf(cl_ - csl[m0]) : 0.f;
                            eb[i] = (m1 <= lrow) ? cb[i] * __expf(cl_ - csl[m1]) : 0.f;
                        }
                        y = MFMA16(pack8(ea, eb), Xd[s2], y);
                    }
                }
                const f32x4 xs = up4(cXs[lt]);
                y = y + xs * dsk;
                u32x2 pk; pk.x = pk2(y[0], y[1]); pk.y = pk2(y[2], y[3]);
                *(u32x2*)(proj + (tok0 + pch) * PC + OXS + j * 64 + 16 * lt + 4 * kg) = pk;
            }
            const float ee = __expf(cend);
#pragma unroll
            for (int nt = 0; nt < 4; ++nt) {
                f32x4 a = St[nt] * ee;
#pragma unroll
                for (int s2 = 0; s2 < 2; ++s2) { const bf16x8 bf = *(const bf16x8*)(B + OBT + (16 * nt + fr) * 144 + (32 * s2 + 8 * kg) * 2); a = MFMA16(bf, Xf[s2], a); }
                St[nt] = a;
            }
        }
        if (n + 1 < 64) {
            commit((n + 1) & 1);
#pragma unroll
            for (int i = 0; i < 2; ++i) cX[i] = gX[i];
#pragma unroll
            for (int i = 0; i < 4; ++i) cXs[i] = gXs[i];
        }
        __syncthreads();
    }
}

__device__ __forceinline__ void s5_carry(const Params& p, int l, int it) {
    float* S5C = (float*)(p.ws + WS_S5C);
    const int idx = it * 512 + otid();
    const int b = idx / 1536, gp = idx % 1536, g = gp >> 6;
    const float re = p.in[10][l * 1536 + gp], im = p.in[11][l * 1536 + gp], dt = __expf(p.in[12][l * 24 + g]);
    const float ea = __expf(64.0f * re * dt), th = 64.0f * im * dt;
    const float lr = ea * cosf(th), li = ea * sinf(th);
    float Xr = 0.f, Xi = 0.f;
    for (int n = 0; n < 64; ++n) {
        const size_t ci = (((size_t)b * 64 + n) * 1536 + gp) * 2;
        const float a = S5C[ci], c = S5C[ci + 1];
        S5C[ci] = Xr; S5C[ci + 1] = Xi;
        const float nr = lr * Xr - li * Xi + a, ni = lr * Xi + li * Xr + c;
        Xr = nr; Xi = ni;
    }
}
__device__ __forceinline__ void lru_carry(const Params& p, int it) {
    float* LA = (float*)(p.ws + WS_LA); float* LH = (float*)(p.ws + WS_LH);
    const int idx = it * 512 + otid();
    const int b = idx >> 9, ch = idx & 511;
    float H = 0.f;
    for (int n = 0; n < 64; ++n) {
        const size_t ci = ((size_t)b * 64 + n) * 512 + ch;
        const float a = LA[ci], hl = LH[ci];
        LH[ci] = H;
        H = a * H + hl;
    }
}

__device__ __forceinline__ void gdn_post(const Params& p, int l, int b, int n, float* sm) {
    bf16_t* proj = (bf16_t*)(p.ws + WS_PROJ);
    const int tid = otid(), wid = __builtin_amdgcn_readfirstlane(tid >> 6), lane = tid & 63;
    const size_t tok0 = (size_t)b * SEQ + n * 64;
    float* Tt = sm;
#pragma unroll 1
    for (int h = 0; h < 4; ++h) {
#pragma unroll
        for (int q = 0; q < 2; ++q) {
            const int idx = tid + 512 * q, grow = idx >> 4, pc = idx & 15, e = 2 * grow + (pc >> 3), c0 = (pc & 7) * 8;
            const u32x4 v = *(const u32x4*)(proj + (tok0 + grow) * PC + OV + h * 128 + pc * 8);
            const f32x4 a = up4((u32x2){v.x, v.y}), bq = up4((u32x2){v.z, v.w});
#pragma unroll
            for (int i = 0; i < 4; ++i) { Tt[e * 65 + c0 + i] = a[i]; Tt[e * 65 + c0 + 4 + i] = bq[i]; }
        }
        __syncthreads();
        const float nw0 = p.in[22][l * 128 + lane], nw1 = p.in[22][l * 128 + lane + 64];
        for (int c = wid * 8; c < wid * 8 + 8; c += 2) {
            const bf16_t* zpa = proj + (tok0 + c) * PC + OZG + h * 128; const bf16_t* zpb = zpa + PC;
            const bf16_t za0 = zpa[lane], za1 = zpa[lane + 64], zb0 = zpb[lane], zb1 = zpb[lane + 64];
            const float a0 = Tt[lane * 65 + c], a1 = Tt[(lane + 64) * 65 + c], b0 = Tt[lane * 65 + c + 1], b1 = Tt[(lane + 64) * 65 + c + 1];
            float sa = a0 * a0 + a1 * a1, sb = b0 * b0 + b1 * b1;
#pragma unroll
            for (int o = 32; o > 0; o >>= 1) { sa += __shfl_xor(sa, o); sb += __shfl_xor(sb, o); }
            const float ra = rsqrtf(sa * (1.0f / 128.0f) + 1e-6f), rb = rsqrtf(sb * (1.0f / 128.0f) + 1e-6f);
            bf16_t* opa = proj + (tok0 + c) * PC + OV + h * 128; bf16_t* opb = opa + PC;
            opa[lane] = f2bf(a0 * ra * nw0 * siluf_(bf2f(za0))); opa[lane + 64] = f2bf(a1 * ra * nw1 * siluf_(bf2f(za1)));
            opb[lane] = f2bf(b0 * rb * nw0 * siluf_(bf2f(zb0))); opb[lane + 64] = f2bf(b1 * rb * nw1 * siluf_(bf2f(zb1)));
        }
        __syncthreads();
    }
}
__device__ __forceinline__ void ssd_post(const Params& p, int l, int b, int n, float* sm) {
    bf16_t* proj = (bf16_t*)(p.ws + WS_PROJ);
    const int tid = otid(), wid = __builtin_amdgcn_readfirstlane(tid >> 6), lane = tid & 63;
    const size_t tok0 = (size_t)b * SEQ + n * 64;
    float* Y = sm;
#pragma unroll
    for (int q = 0; q < 8; ++q) {
        const int idx = tid + 512 * q, j = idx >> 9, prow = (idx >> 3) & 63, pc = idx & 7;
        const u32x4 v = *(const u32x4*)(proj + (tok0 + prow) * PC + OXS + j * 64 + pc * 8);
        const f32x4 a = up4((u32x2){v.x, v.y}), bq = up4((u32x2){v.z, v.w});
#pragma unroll
        for (int i = 0; i < 4; ++i) { Y[(pc * 8 + i) * 516 + j * 64 + prow] = a[i]; Y[(pc * 8 + 4 + i) * 516 + j * 64 + prow] = bq[i]; }
    }
    __syncthreads();
    for (int r = wid * 8; r < wid * 8 + 8; ++r) {
        bf16_t* yp = proj + (tok0 + r) * PC + OXS;
        const bf16_t* zp = proj + (tok0 + r) * PC + OZS;
        float v[8]; float ss = 0.f;
#pragma unroll
        for (int k = 0; k < 8; ++k) { const int c = lane + 64 * k; v[k] = Y[r * 516 + c] * siluf_(bf2f(zp[c])); ss += v[k] * v[k]; }
        ss = wave_sum(ss);
        const float rstd = rsqrtf(ss * (1.0f / 512.0f) + 1e-6f);
#pragma unroll
        for (int k = 0; k < 8; ++k) { const int c = lane + 64 * k; yp[c] = f2bf(v[k] * rstd * p.in[26][l * 512 + c]); }
    }
    __syncthreads();
}

#define OPQ(v) asm volatile("" : "+s"(v))
#define FRESHP const Params& p = *kparams(); float* mod = (float*)(p.ws + WS_MOD); bf16_t* proj = (bf16_t*)(p.ws + WS_PROJ); bf16_t* hbuf = (bf16_t*)(p.ws + WS_H); bf16_t* mbuf = (bf16_t*)(p.ws + WS_M); const float* modl = mod + (size_t)l * 8 * 6144; const float* xin = (l == 0) ? p.in[0] : p.out; (void)proj; (void)hbuf; (void)mbuf; (void)modl; (void)xin;
template <int LL> __device__ __forceinline__ void run_layer(float* sm, LAS unsigned char* lds) {
    int l = LL;
        { FRESHP convert_layer(p, l, sm); }
        if (l == 0) cg::this_grid().sync();
        OPQ(l);
        { FRESHP norm_phase(xin, p.in[2] + l * 1024, modl, 0, 1024, hbuf); }
        cg::this_grid().sync(); OPQ(l);
        { FRESHP ProgProj pg; pg.ord.init(128, 19, ogrid(), obid()); pg.A = (const char*)hbuf; pg.B = (const char*)(p.ws + WS_BTIN); pg.proj = proj; pg.halo = (bf16_t*)(p.ws + WS_HALO); gemm_run(lds, pg); }
        cg::this_grid().sync(); OPQ(l);
        { FRESHP for (int it = obid(), G = ogrid(); it < 2048 + 1536; it += G) {
            if (it < 2048) { const int tl = it >> 2, h = it & 3; gdn_prep(p, l, tl >> 6, tl & 63, h, sm); }
            else { const int r = it - 2048, part = r / 512, tl = r % 512; const int b = tl >> 6, n = tl & 63;
                if (part == 0) ssd_prep(p, l, b, n, sm); else if (part == 1) lru_chunk<0>(p, l, b, n, sm); else s5_chunk<0>(p, l, b, n, sm); }
        } }
        cg::this_grid().sync(); OPQ(l);
        { FRESHP for (int it = obid(), G = ogrid(); it < 64 + 64 + 24 + 8; it += G) {
            if (it < 64) gdn_seq(p, it >> 3, (it >> 1) & 3, it & 1, sm);
            else if (it < 128) { const int r = it - 64; ssd_seq(p, l, r >> 3, r & 7, sm); }
            else if (it < 152) s5_carry(p, l, it - 128);
            else lru_carry(p, it - 152);
            __syncthreads();
        } }
        cg::this_grid().sync(); OPQ(l);
        { FRESHP for (int it = obid(), G = ogrid(); it < 2048; it += G) {
            const int part = it / 512, tl = it % 512; const int b = tl >> 6, n = tl & 63;
            if (part == 0) s5_chunk<1>(p, l, b, n, sm); else if (part == 1) lru_chunk<1>(p, l, b, n, sm); else if (part == 2) gdn_post(p, l, b, n, sm); else ssd_post(p, l, b, n, sm);
        } }
        cg::this_grid().sync(); OPQ(l);
        { FRESHP ProgMerge pg; pg.ord.init(128, 4, ogrid(), obid()); pg.H = (const char*)hbuf; pg.Bg = (const char*)(p.ws + WS_BTIN) + (size_t)PC * 1024 * 2; pg.Bb = (const char*)(p.ws + WS_BTBR); pg.P = (const char*)proj; pg.proj = proj; pg.mb = mbuf; gemm_run(lds, pg); }
        cg::this_grid().sync(); OPQ(l);
        { FRESHP ProgRes pg; pg.ord.init(128, 4, ogrid(), obid()); pg.A = (const char*)mbuf; pg.B = (const char*)(p.ws + WS_BTOUT); pg.lda = 1024; pg.nt = 16; pg.xin = xin; pg.xout = p.out; pg.gt = modl + 2048; gemm_run(lds, pg); }
        cg::this_grid().sync(); OPQ(l);
        { FRESHP norm_phase(p.out, p.in[3] + l * 1024, modl, 3072, 4096, hbuf); }
        cg::this_grid().sync(); OPQ(l);
        { FRESHP ProgSwi pg; pg.ord.init(128, 22, ogrid(), obid()); pg.A = (const char*)hbuf; pg.B = (const char*)(p.ws + WS_BT13); pg.act = proj; gemm_run(lds, pg); }
        cg::this_grid().sync(); OPQ(l);
        { FRESHP ProgRes pg; pg.ord.init(128, 4, ogrid(), obid()); pg.A = (const char*)proj; pg.B = (const char*)(p.ws + WS_BT2); pg.lda = FH; pg.nt = 44; pg.xin = p.out; pg.xout = p.out; pg.gt = modl + 5120; gemm_run(lds, pg); }
        cg::this_grid().sync(); OPQ(l);
    }

__global__ void __launch_bounds__(512) trunk_fwd(Params p_unused) {
    extern __shared__ __attribute__((aligned(16))) unsigned char smem[];
    float* sm = (float*)smem;
    LAS unsigned char* lds = (LAS unsigned char*)smem;

    { const Params& p = *kparams(); mod_phase(p, sm); }
    run_layer<0>(sm, lds);
    run_layer<1>(sm, lds);
    { const Params& p = *kparams(); final_norm_phase(p.out, p.in[4]); }
}

extern "C" void kernel_launch(void* const* d_in, const int* in_sizes, int n_in, void* d_out, int out_size, void* d_ws, size_t ws_size, hipStream_t stream) {
    static int grid = 0;
    if (grid == 0) {
        if (n_in != 36 || ws_size < WS_END) { fprintf(stderr, "kernel_launch: need 36 inputs and >= %zu bytes of workspace; got %d, %zu\n", (size_t)WS_END, n_in, ws_size); grid = -1; return; }
        int dev = 0, cus = 0, per_cu = 0;
        (void)hipGetDevice(&dev);
        (void)hipDeviceGetAttribute(&cus, hipDeviceAttributeMultiprocessorCount, dev);
        if (hipFuncSetAttribute((const void*)trunk_fwd, hipFuncAttributeMaxDynamicSharedMemorySize, LDS_BYTES) != hipSuccess) { fprintf(stderr, "kernel_launch: hipFuncSetAttribute failed\n"); grid = -1; return; }
        if (hipOccupancyMaxActiveBlocksPerMultiprocessor(&per_cu, (const void*)trunk_fwd, 512, LDS_BYTES) != hipSuccess || per_cu < 1) { fprintf(stderr, "kernel_launch: occupancy query says %d\n", per_cu); per_cu = 1; }
        (void)hipGetLastError();
        grid = cus * 1;
    }
    if (grid < 0) return;
    Params p{};
    for (int i = 0; i < 36; ++i) p.in[i] = (const float*)d_in[i];
    p.out = (float*)d_out; p.ws = (unsigned char*)d_ws;
    void* args[] = {&p};
    hipError_t e = hipLaunchCooperativeKernel((const void*)trunk_fwd, dim3(grid), dim3(512), args, LDS_BYTES, stream);
    if (e != hipSuccess) fprintf(stderr, "cooperative launch failed: %s (grid %d)\n", hipGetErrorString(e), grid);
}
```

```cpp
#include <hip/hip_runtime.h>
#include <hip/hip_cooperative_groups.h>
#include <cstdio>
namespace cg = cooperative_groups;

#define LAS __attribute__((address_space(3)))
typedef unsigned short bf16_t;
typedef short bf16x8 __attribute__((ext_vector_type(8)));
typedef float f32x4 __attribute__((ext_vector_type(4)));
typedef float f32x2 __attribute__((ext_vector_type(2)));
typedef unsigned u32x2 __attribute__((ext_vector_type(2)));
typedef unsigned u32x4 __attribute__((ext_vector_type(4)));

constexpr int T_ = 32768, D_ = 1024, NB = 8, SEQ = 4096, NCH = 64, PC = 4752, INC = 8848, CONVC = 2816, FH = 2816;
constexpr int OQ = 0, OKK = 512, OV = 1024, OXS = 1536, OBS = 2048, OCS = 2176, OXL = 2304, OU5 = 2816, OBG = 3200, OAG = 3204, OZG = 3208, OZS = 3720, ODT = 4232, OGL = 4240;
constexpr size_t WS_BTIN = 0, WS_BTBR = 18120704, WS_BTOUT = 22052864, WS_BT13 = 24150016, WS_BT2 = 35684352, WS_H = 41451520, WS_M = 108560384,
                 WS_PROJ = 175669248, WS_HALO = 487096320, WS_MOD = 495747072, WS_DT = 496140288, WS_CS = 497188864, WS_GC = 498237440, WS_S5C = 498761728,
                 WS_LA = 505053184, WS_LH = 506101760, WS_PAR = 507150336, WS_END = 507150336 + 1024 * 512;
constexpr int LDS_BYTES = 160 * 1024;

struct Params {
    const float* in[36];
    float* out;
    unsigned char* ws;
};

__device__ __forceinline__ int otid() { int t = threadIdx.x; asm volatile("" : "+v"(t)); return t; }
__device__ __forceinline__ int obid() { int t = blockIdx.x; asm volatile("" : "+s"(t)); return t; }
struct Params;
__device__ __forceinline__ const Params* kparams() { auto k = __builtin_amdgcn_kernarg_segment_ptr(); asm volatile("" : "+s"(k)); return (const Params*)k; }
__device__ __forceinline__ int ogrid() { int t = gridDim.x; asm volatile("" : "+s"(t)); return t; }
__device__ __forceinline__ float bf2f(bf16_t v) { return __uint_as_float(((unsigned)v) << 16); }
__device__ __forceinline__ bf16_t f2bf(float f) { unsigned r; asm("v_cvt_pk_bf16_f32 %0, %1, %1" : "=v"(r) : "v"(f)); return (bf16_t)(r & 0xffffu); }
__device__ __forceinline__ unsigned pk2(float lo, float hi) { unsigned r; asm("v_cvt_pk_bf16_f32 %0, %1, %2" : "=v"(r) : "v"(lo), "v"(hi)); return r; }
__device__ __forceinline__ float sigmoidf_(float x) { return __builtin_amdgcn_rcpf(1.0f + __expf(-x)); }
__device__ __forceinline__ float siluf_(float x) { return x * __builtin_amdgcn_rcpf(1.0f + __expf(-x)); }
__device__ __forceinline__ float softplusf_(float x) { return fmaxf(x, 0.f) + log1pf(__expf(-fabsf(x))); }
__device__ __forceinline__ float geluf_(float x) { const float u = 0.7978845608028654f * (x + 0.044715f * x * x * x); return x - x * __builtin_amdgcn_rcpf(1.0f + __expf(2.0f * u)); }
__device__ __forceinline__ int pperm(int d) { return (d & ~31) | (((d >> 2) & 3) << 3) | (((d >> 4) & 1) << 2) | (d & 3); }
__device__ __forceinline__ int iperm(int q) { return (q & ~31) | (((q >> 2) & 1) << 4) | (((q >> 3) & 3) << 2) | (q & 3); }
__device__ __forceinline__ bf16x8 pack8(const f32x4 a, const f32x4 b) { u32x4 r; r.x = pk2(a[0], a[1]); r.y = pk2(a[2], a[3]); r.z = pk2(b[0], b[1]); r.w = pk2(b[2], b[3]); return __builtin_bit_cast(bf16x8, r); }
__device__ __forceinline__ f32x4 up4(u32x2 v) { f32x4 r; r[0] = __uint_as_float(v.x << 16); r[1] = __uint_as_float(v.x & 0xffff0000u); r[2] = __uint_as_float(v.y << 16); r[3] = __uint_as_float(v.y & 0xffff0000u); return r; }
__device__ __forceinline__ float wave_incl_scan(float v, int lane) {
#pragma unroll
    for (int o = 1; o < 64; o <<= 1) { const float t = __shfl_up(v, o); if (lane >= o) v += t; }
    return v;
}
__device__ __forceinline__ float wave_sum(float v) {
#pragma unroll
    for (int o = 32; o > 0; o >>= 1) v += __shfl_xor(v, o);
    return v;
}

constexpr int HTB = 128 * 64 * 2;
__device__ __forceinline__ int lds_byte(int r, int c) { const int st = (r >> 4) * 2 + (c >> 5), rr = r & 15, cc = c & 31, ob = rr * 64 + cc * 2; return st * 1024 + (ob ^ (((ob >> 9) & 1) << 5)); }
__device__ __forceinline__ void stage_rc(int b, int& R, int& C) { const int st = b / 1024, sb = b % 1024, swz = sb ^ (((sb >> 9) & 1) << 5); R = (st >> 1) * 16 + swz / 64; C = (st & 1) * 32 + (swz % 64) / 2; }

__device__ __forceinline__ int perm32(int rho) { const int n = rho >> 4, i = rho & 15; return 8 * (i >> 2) + 4 * n + (i & 3); }
struct GU { const char* A; const char* B; int lda; int nt; int pm, pn, sub; };

struct TileOrder {
    int nM, nN, nwg, G, c;
    __device__ void init(int nM_, int nN_, int G_, int c_) { nM = nM_; nN = nN_; nwg = nM * nN; G = G_; c = c_; }
    __device__ bool tile(int i, int& pm, int& pn) const {
        const long L = (long)i * G + c; if (L >= nwg) return false;
        int wgid = (int)L; { const int q = nwg / 8, r = nwg % 8, xcd = wgid % 8, off = wgid / 8; wgid = (xcd < r ? xcd * (q + 1) : r * (q + 1) + (xcd - r) * q) + off; }
        const int nig = 8 * nN, gid = wgid / nig, fm = gid * 8, gsz = (nM - fm) < 8 ? (nM - fm) : 8;
        pm = fm + ((wgid % nig) % gsz); pn = (wgid % nig) / gsz; return true;
    }
};

template <class P>
__device__ __forceinline__ void gemm_run(LAS unsigned char* lds, const P& prog) {
    const int tid = otid(), wid = __builtin_amdgcn_readfirstlane(tid >> 6), lane = tid & 63, wr = wid >> 2, wc = wid & 3, fr = lane & 15, fq = lane >> 4;
    const unsigned ldsw = (unsigned)wid * 1024u;
    const int aoff = lds_byte(wr * 64 + fr, fq * 8), boff = lds_byte(wc * 32 + fr, fq * 8);
#define G_SA(b, h) (((b) * 2 + (h)) * HTB)
#define G_SB(b, h) ((4 + (b) * 2 + (h)) * HTB)
#define G_STAGE(bufoff, gbase, voff) do { _Pragma("unroll") for (int _i = 0; _i < 2; ++_i) \
        __builtin_amdgcn_global_load_lds((const unsigned*)((const char*)(gbase) + (voff)[_i]), (LAS unsigned*)(lds + (bufoff) + ldsw + _i * 8192), 16, 0, 0); } while (0)
#define G_LDA(dst, b, h) do { _Pragma("unroll") for (int m = 0; m < 4; ++m) _Pragma("unroll") for (int k = 0; k < 2; ++k) dst[m][k] = *(const LAS bf16x8*)(lds + G_SA(b, h) + aoff + m * 2048 + k * 1024); } while (0)
#define G_LDB(dst, b, h) do { _Pragma("unroll") for (int n = 0; n < 2; ++n) _Pragma("unroll") for (int k = 0; k < 2; ++k) dst[n][k] = *(const LAS bf16x8*)(lds + G_SB(b, h) + boff + n * 2048 + k * 1024); } while (0)
#define G_MMA(ai, bj, At, Bt) do { __builtin_amdgcn_s_setprio(1); _Pragma("unroll") for (int m = 0; m < 4; ++m) _Pragma("unroll") for (int n = 0; n < 2; ++n) _Pragma("unroll") for (int k = 0; k < 2; ++k) \
        acc[ai][bj][m][n] = __builtin_amdgcn_mfma_f32_16x16x32_bf16(Bt[n][k], At[m][k], acc[ai][bj][m][n], 0, 0, 0); __builtin_amdgcn_s_setprio(0); } while (0)
#define G_WAIT_V(n) asm volatile("s_waitcnt vmcnt(" #n ")" ::: "memory")
#define G_WAIT_L(n) asm volatile("s_waitcnt lgkmcnt(" #n ")" ::: "memory")
#define G_BAR __builtin_amdgcn_s_barrier()
#define G_SCHED __builtin_amdgcn_sched_barrier(0)
    GU cur, nxt; int ui = 0;
    if (!prog.get(0, cur)) return;
    f32x4 acc[2][2][4][2];
#pragma unroll
    for (int a = 0; a < 2; ++a)
#pragma unroll
        for (int b = 0; b < 2; ++b)
#pragma unroll
            for (int m = 0; m < 4; ++m)
#pragma unroll
                for (int n = 0; n < 2; ++n) acc[a][b][m][n] = (f32x4){0.f, 0.f, 0.f, 0.f};
    bf16x8 At[4][2], B0[2][2], B1[2][2];
    unsigned cvA[2], cvB[2], nvA[2], nvB[2];
#pragma unroll
    for (int i = 0; i < 2; ++i) { int R, C; stage_rc(tid * 16 + i * 8192, R, C); const int Rb = 64 * (R >> 5) + perm32(R & 31); cvA[i] = (unsigned)(R * cur.lda + C) * 2u; cvB[i] = (unsigned)(Rb * cur.nt * 64 + C) * 2u; }
    unsigned chA = 256u * cur.lda, chB = 64u * cur.nt * 64;
    const size_t kstep = 128;
    const char* cA = cur.A; const char* cB = cur.B;
    G_STAGE(G_SB(0, 0), cB, cvB); G_STAGE(G_SA(0, 0), cA, cvA); G_STAGE(G_SB(0, 1), cB + chB, cvB); G_STAGE(G_SA(0, 1), cA + chA, cvA);
    if (wr == 1) G_BAR;
    G_WAIT_V(4); G_BAR;
    G_STAGE(G_SB(1, 0), cB + kstep, cvB); G_STAGE(G_SA(1, 0), cA + kstep, cvA); G_STAGE(G_SB(1, 1), cB + chB + kstep, cvB);
    G_WAIT_V(6); G_BAR;
    for (;;) {
        const bool has_next = prog.get(ui + 1, nxt);
        if (!has_next) nxt = cur;
        const char* nA = nxt.A; const char* nB = nxt.B;
        { int t2 = tid; asm volatile("" : "+v"(t2));
#pragma unroll
          for (int i = 0; i < 2; ++i) { int R, C; stage_rc(t2 * 16 + i * 8192, R, C); const int Rb = 64 * (R >> 5) + perm32(R & 31); nvA[i] = (unsigned)(R * nxt.lda + C) * 2u; nvB[i] = (unsigned)(Rb * nxt.nt * 64 + C) * 2u; } }
        const unsigned nhA = 256u * nxt.lda, nhB = 64u * nxt.nt * 64;
        const int nt = cur.nt;
        for (int t = 0; t < nt; t += 2) {
            const bool last = (t == nt - 2);
            const char* a1 = cA + (size_t)(t + 1) * kstep;
            const char* a2 = last ? nA : cA + (size_t)(t + 2) * kstep; const char* b2 = last ? nB : cB + (size_t)(t + 2) * kstep;
            const char* a3 = a2 + kstep; const char* b3 = b2 + kstep;
            unsigned vA2[2], vB2[2];
#pragma unroll
            for (int i = 0; i < 2; ++i) { vA2[i] = last ? nvA[i] : cvA[i]; vB2[i] = last ? nvB[i] : cvB[i]; }
            const unsigned hA2 = last ? nhA : chA, hB2 = last ? nhB : chB;
            G_LDB(B0, 0, 0); G_SCHED; G_LDA(At, 0, 0); G_STAGE(G_SA(1, 1), a1 + chA, cvA);
            G_WAIT_L(8); G_BAR; G_WAIT_L(0); G_MMA(0, 0, At, B0); G_BAR; G_SCHED;
            G_LDB(B1, 0, 1); G_STAGE(G_SB(0, 0), b2, vB2);
            G_BAR; G_WAIT_L(0); G_MMA(0, 1, At, B1); G_BAR;
            G_LDA(At, 0, 1); G_STAGE(G_SA(0, 0), a2, vA2);
            G_BAR; G_WAIT_L(0); G_MMA(1, 0, At, B0); G_BAR; G_SCHED;
            G_STAGE(G_SB(0, 1), b2 + hB2, vB2);
            G_WAIT_V(6); G_BAR; G_MMA(1, 1, At, B1); G_BAR;
            G_LDB(B0, 1, 0); G_SCHED; G_LDA(At, 1, 0); G_STAGE(G_SA(0, 1), a2 + hA2, vA2);
            G_WAIT_L(8); G_BAR; G_WAIT_L(0); G_MMA(0, 0, At, B0); G_BAR; G_SCHED;
            G_LDB(B1, 1, 1); G_STAGE(G_SB(1, 0), b3, vB2);
            G_BAR; G_WAIT_L(0); G_MMA(0, 1, At, B1); G_BAR;
            G_LDA(At, 1, 1); G_STAGE(G_SA(1, 0), a3, vA2);
            G_BAR; G_WAIT_L(0); G_MMA(1, 0, At, B0); G_BAR; G_SCHED;
            G_STAGE(G_SB(1, 1), b3 + hB2, vB2);
            G_WAIT_V(6); G_BAR; G_MMA(1, 1, At, B1); G_BAR;
        }
        prog.epi(acc, cur, wr, wc, fr, fq);
        if (!has_next) break;
#pragma unroll
        for (int a = 0; a < 2; ++a)
#pragma unroll
            for (int b = 0; b < 2; ++b)
#pragma unroll
                for (int m = 0; m < 4; ++m)
#pragma unroll
                    for (int n = 0; n < 2; ++n) acc[a][b][m][n] = (f32x4){0.f, 0.f, 0.f, 0.f};
        cur = nxt; cA = nA; cB = nB; chA = nhA; chB = nhB;
#pragma unroll
        for (int i = 0; i < 2; ++i) { cvA[i] = nvA[i]; cvB[i] = nvB[i]; }
        ++ui;
    }
    G_WAIT_V(0);
    if (wr == 0) G_BAR;
    G_BAR;
#undef G_SA
#undef G_SB
#undef G_STAGE
#undef G_LDA
#undef G_LDB
#undef G_MMA
#undef G_WAIT_V
#undef G_WAIT_L
#undef G_BAR
#undef G_SCHED
}

struct ProgProj {
    TileOrder ord; const char* A; const char* B; bf16_t* proj; bf16_t* halo;
    __device__ bool get(int i, GU& u) const { if (!ord.tile(i, u.pm, u.pn)) return false; u.A = A + (size_t)u.pm * 256 * 1024 * 2; u.B = B + (size_t)u.pn * 256 * 1024 * 2; u.lda = 1024; u.nt = 16; u.sub = 0; return true; }
    __device__ __forceinline__ void epi(const f32x4 (&acc)[2][2][4][2], const GU& u, int wr, int wc, int fr, int fq) const {
#pragma unroll
        for (int ai = 0; ai < 2; ++ai)
#pragma unroll
            for (int m = 0; m < 4; ++m) {
                const int row = u.pm * 256 + ai * 128 + wr * 64 + m * 16 + fr;
                const int r6 = row & 63;
#pragma unroll
                for (int bj = 0; bj < 2; ++bj) {
                    const int col = u.pn * 256 + wc * 64 + bj * 32 + 8 * fq;
                    const f32x4 v0 = acc[ai][bj][m][0], v1 = acc[ai][bj][m][1];
                    u32x4 pk; pk.x = pk2(v0[0], v0[1]); pk.y = pk2(v0[2], v0[3]); pk.z = pk2(v1[0], v1[1]); pk.w = pk2(v1[2], v1[3]);
                    if (col < PC) *(u32x4*)(proj + (size_t)row * PC + col) = pk;
                    if (col < CONVC && r6 >= 61) *(u32x4*)(halo + ((size_t)(row >> 6) * 3 + (r6 - 61)) * CONVC + col) = pk;
                }
            }
    }
};

struct ProgMerge {
    TileOrder ord; const char* H; const char* Bg; const char* Bb; const char* P; bf16_t* proj; bf16_t* mb;
    __device__ bool get(int i, GU& u) const {
        const int tl = i >> 3, sub = i & 7;
        if (!ord.tile(tl, u.pm, u.pn)) return false;
        u.sub = sub; const int br = sub >> 1;
        if (!(sub & 1)) { u.A = H + (size_t)u.pm * 256 * 1024 * 2; u.lda = 1024; u.nt = 16; u.B = Bg + ((size_t)br * 1024 + (size_t)u.pn * 256) * 1024 * 2; }
        else {
            const int kb = (br == 0) ? 384 : 512; const int ycol = (br == 0) ? OU5 : (br == 1) ? OV : (br == 2) ? OXS : OXL; const int koff = (br == 0) ? 0 : 384 + (br - 1) * 512;
            u.A = P + ((size_t)u.pm * 256 * PC + ycol) * 2; u.lda = PC; u.nt = kb / 64; u.B = Bb + (size_t)koff * 1024 * 2 + (size_t)u.pn * 256 * kb * 2;
        }
        return true;
    }
    __device__ __forceinline__ void epi(const f32x4 (&acc)[2][2][4][2], const GU& u, int wr, int wc, int fr, int fq) const {
        const int sub = u.sub;
#pragma unroll
        for (int ai = 0; ai < 2; ++ai)
#pragma unroll
            for (int m = 0; m < 4; ++m) {
                const int row = u.pm * 256 + ai * 128 + wr * 64 + m * 16 + fr;
#pragma unroll
                for (int bj = 0; bj < 2; ++bj) {
                    const int col = u.pn * 256 + wc * 64 + bj * 32 + 8 * fq;
                    const f32x4 v0 = acc[ai][bj][m][0], v1 = acc[ai][bj][m][1];
                    bf16_t* st = proj + (size_t)row * PC + col;
                    bf16_t* mp = mb + (size_t)row * 1024 + col;
                    if (!(sub & 1)) {
                        u32x4 pk; pk.x = pk2(sigmoidf_(v0[0]), sigmoidf_(v0[1])); pk.y = pk2(sigmoidf_(v0[2]), sigmoidf_(v0[3])); pk.z = pk2(sigmoidf_(v1[0]), sigmoidf_(v1[1])); pk.w = pk2(sigmoidf_(v1[2]), sigmoidf_(v1[3]));
                        *(u32x4*)st = pk;
                    } else {
                        const u32x4 g = *(const u32x4*)st;
                        f32x4 r0 = up4((u32x2){g.x, g.y}) * v0, r1 = up4((u32x2){g.z, g.w}) * v1;
                        if (sub > 1) { const u32x4 o = *(const u32x4*)mp; r0 = r0 + up4((u32x2){o.x, o.y}); r1 = r1 + up4((u32x2){o.z, o.w}); }
                        u32x4 pk; pk.x = pk2(r0[0], r0[1]); pk.y = pk2(r0[2], r0[3]); pk.z = pk2(r1[0], r1[1]); pk.w = pk2(r1[2], r1[3]);
                        *(u32x4*)mp = pk;
                    }
                }
            }
    }
};

struct ProgRes {
    TileOrder ord; const char* A; const char* B; int lda, nt; const float* xin; float* xout; const float* gt;
    __device__ bool get(int i, GU& u) const { if (!ord.tile(i, u.pm, u.pn)) return false; u.A = A + (size_t)u.pm * 256 * lda * 2; u.B = B + (size_t)u.pn * 256 * (nt * 64) * 2; u.lda = lda; u.nt = nt; u.sub = 0; return true; }
    __device__ __forceinline__ void epi(const f32x4 (&acc)[2][2][4][2], const GU& u, int wr, int wc, int fr, int fq) const {
        const int bidx = (u.pm * 256) >> 12;
#pragma unroll
        for (int bj = 0; bj < 2; ++bj)
#pragma unroll
            for (int n = 0; n < 2; ++n) {
                const int col = u.pn * 256 + wc * 64 + bj * 32 + 8 * fq + 4 * n;
                const f32x4 g = *(const f32x4*)(gt + (size_t)bidx * 6144 + col);
#pragma unroll
                for (int ai = 0; ai < 2; ++ai)
#pragma unroll
                    for (int mp = 0; mp < 2; ++mp) {
                        const int row0 = u.pm * 256 + ai * 128 + wr * 64 + (2 * mp) * 16 + fr, row1 = row0 + 16;
                        const f32x4 xa = *(const f32x4*)(xin + (size_t)row0 * 1024 + col), xb2 = *(const f32x4*)(xin + (size_t)row1 * 1024 + col);
                        *(f32x4*)(xout + (size_t)row0 * 1024 + col) = xa + g * acc[ai][bj][2 * mp][n];
                        *(f32x4*)(xout + (size_t)row1 * 1024 + col) = xb2 + g * acc[ai][bj][2 * mp + 1][n];
                    }
            }
    }
};

struct ProgSwi {
    TileOrder ord; const char* A; const char* B; bf16_t* act;
    __device__ bool get(int i, GU& u) const { if (!ord.tile(i, u.pm, u.pn)) return false; u.A = A + (size_t)u.pm * 256 * 1024 * 2; u.B = B + (size_t)u.pn * 256 * 1024 * 2; u.lda = 1024; u.nt = 16; u.sub = 0; return true; }
    __device__ __forceinline__ void epi(const f32x4 (&acc)[2][2][4][2], const GU& u, int wr, int wc, int fr, int fq) const {
#pragma unroll
        for (int ai = 0; ai < 2; ++ai)
#pragma unroll
            for (int m = 0; m < 4; ++m) {
                const int row = u.pm * 256 + ai * 128 + wr * 64 + m * 16 + fr;
                const int col = u.pn * 128 + wc * 32 + 8 * fq;
                const f32x4 a0 = acc[ai][0][m][0], b0 = acc[ai][1][m][0], a1 = acc[ai][0][m][1], b1 = acc[ai][1][m][1];
                u32x4 pk; pk.x = pk2(siluf_(a0[0]) * b0[0], siluf_(a0[1]) * b0[1]); pk.y = pk2(siluf_(a0[2]) * b0[2], siluf_(a0[3]) * b0[3]);
                pk.z = pk2(siluf_(a1[0]) * b1[0], siluf_(a1[1]) * b1[1]); pk.w = pk2(siluf_(a1[2]) * b1[2], siluf_(a1[3]) * b1[3]);
                *(u32x4*)(act + (size_t)row * FH + col) = pk;
            }
    }
};

struct CDesc { const float* src; bf16_t* dst; int ld_src, k0, n0, nmax, ld_dst, mode; };
__device__ __forceinline__ void convert_decode(const Params& p, int l, int it, CDesc& d) {
    int j, r = it;
    if (r < 2224) j = 0; else if (r < 2320) { j = 1; r -= 2224; } else if (r < 2448) { j = 2; r -= 2320; } else if (r < 2576) { j = 3; r -= 2448; } else if (r < 2704) { j = 4; r -= 2576; }
    else if (r < 2960) { j = 5; r -= 2704; } else if (r < 4368) { j = 6; r -= 2960; } else if (r < 5072) { j = 7; r -= 4368; } else if (r < 5108) { j = 8; r -= 5072; } else { j = 9; r -= 5108; }
    int KT; d.mode = 0;
    if (j == 0) { d.src = p.in[7] + (size_t)l * 1024 * INC; d.ld_src = INC; KT = 16; d.nmax = INC; d.dst = (bf16_t*)(p.ws + WS_BTIN); d.ld_dst = 1024; }
    else if (j <= 4) { const int br = j - 1; const int kb = br == 0 ? 384 : 512, koff = br == 0 ? 0 : 384 + (br - 1) * 512;
        d.src = p.in[32] + (size_t)l * 1920 * 1024 + (size_t)koff * 1024; d.ld_src = 1024; KT = kb / 64; d.nmax = 1024; d.dst = (bf16_t*)(p.ws + WS_BTBR) + (size_t)koff * 1024; d.ld_dst = kb; }
    else if (j == 5) { d.src = p.in[33] + (size_t)l * 1024 * 1024; d.ld_src = 1024; KT = 16; d.nmax = 1024; d.dst = (bf16_t*)(p.ws + WS_BTOUT); d.ld_dst = 1024; }
    else if (j == 6) { d.src = p.in[34] + (size_t)l * 1024 * 5632; d.ld_src = 5632; KT = 16; d.nmax = 5632; d.dst = (bf16_t*)(p.ws + WS_BT13); d.ld_dst = 1024; d.mode = 1; }
    else if (j == 7) { d.src = p.in[35] + (size_t)l * FH * 1024; d.ld_src = 1024; KT = 44; d.nmax = 1024; d.dst = (bf16_t*)(p.ws + WS_BT2); d.ld_dst = FH; }
    else if (j == 8) { d.src = p.in[18] + (size_t)l * 384 * 384; d.ld_src = 384; KT = 6; d.nmax = 384; d.dst = (bf16_t*)(p.ws + WS_PAR); d.ld_dst = 384; }
    else { const int gate = r >> 3, nb = r & 7; d.src = (gate ? p.in[30] : p.in[28]) + (size_t)(l * 8 + nb) * 4096; d.ld_src = 64; KT = 1; d.nmax = 64; d.dst = (bf16_t*)(p.ws + WS_PAR + 294912) + (size_t)(gate * 8 + nb) * 4096; d.ld_dst = 64; r = 0; }
    d.n0 = (r / KT) * 64; d.k0 = (r % KT) * 64;
}
__device__ __forceinline__ void convert_layer(const Params& p, int l, float* sm) {
    const int total = 5124;
    const int tid = otid(), G = ogrid();
    int it = obid();
    if (it >= total) return;
    CDesc d; convert_decode(p, l, it, d);
    float v[8];
    {
        const int nn = tid & 63, n = d.n0 + nn;
#pragma unroll
        for (int i = 0; i < 8; ++i) { const int kk = (tid >> 6) + 8 * i; v[i] = (n < d.nmax) ? d.src[(size_t)(d.k0 + kk) * d.ld_src + n] : 0.f; }
    }
    int buf = 0;
    for (;;) {
        float* T = sm + buf * 4160;
        {
            const int nn = tid & 63;
#pragma unroll
            for (int i = 0; i < 8; ++i) { const int kk = (tid >> 6) + 8 * i; T[kk * 65 + nn] = v[i]; }
        }
        const bool has_next = (it + G < total);
        CDesc dn = d;
        if (has_next) {
            convert_decode(p, l, it + G, dn);
            const int nn = tid & 63, n = dn.n0 + nn;
#pragma unroll
            for (int i = 0; i < 8; ++i) { const int kk = (tid >> 6) + 8 * i; v[i] = (n < dn.nmax) ? dn.src[(size_t)(dn.k0 + kk) * dn.ld_src + n] : 0.f; }
        }
        __syncthreads();
        {
            const int nn2 = tid >> 3, kk2 = (tid & 7) * 8, n = d.n0 + nn2;
            if (n < d.nmax) {
                int row = n;
                if (d.mode == 1) row = (n < FH) ? ((n >> 5) * 64 + (n & 31)) : ((((n - FH) >> 5) * 64) + 32 + ((n - FH) & 31));
                u32x4 pk;
                pk.x = pk2(T[(kk2 + 0) * 65 + nn2], T[(kk2 + 1) * 65 + nn2]); pk.y = pk2(T[(kk2 + 2) * 65 + nn2], T[(kk2 + 3) * 65 + nn2]);
                pk.z = pk2(T[(kk2 + 4) * 65 + nn2], T[(kk2 + 5) * 65 + nn2]); pk.w = pk2(T[(kk2 + 6) * 65 + nn2], T[(kk2 + 7) * 65 + nn2]);
                *(u32x4*)(d.dst + (size_t)row * d.ld_dst + d.k0 + kk2) = pk;
            }
        }
        if (!has_next) break;
        d = dn; it += G; buf ^= 1;
    }
    __syncthreads();
}

__device__ __forceinline__ void mod_phase(const Params& p, float* sm) {
    float* cond = sm;
    float* part = sm + 8192;
    float* mod = (float*)(p.ws + WS_MOD);
    const int tid = otid();
    for (int it = obid(); it < 96; it += ogrid()) {
        const int l = it / 48, cb = it % 48;
        for (int i = tid; i < 8192; i += 512) cond[i] = siluf_(p.in[1][i]);
        __syncthreads();
        const int cl = tid & 127, ks = tid >> 7, col = cb * 128 + cl;
        float a[8];
#pragma unroll
        for (int b = 0; b < 8; ++b) a[b] = 0.f;
        const float* w = p.in[5] + (size_t)l * 1024 * 6144 + col;
#pragma unroll 2
        for (int k = ks * 256; k < ks * 256 + 256; k += 4) {
            const float w0 = w[(size_t)k * 6144], w1 = w[(size_t)(k + 1) * 6144], w2 = w[(size_t)(k + 2) * 6144], w3 = w[(size_t)(k + 3) * 6144];
#pragma unroll
            for (int b = 0; b < 8; ++b) { const f32x4 c4 = *(const f32x4*)(cond + b * 1024 + k); a[b] += c4[0] * w0 + c4[1] * w1 + c4[2] * w2 + c4[3] * w3; }
        }
#pragma unroll
        for (int b = 0; b < 8; ++b) part[(ks * 8 + b) * 128 + cl] = a[b];
        __syncthreads();
        for (int i = tid; i < 1024; i += 512) {
            const int b = i >> 7, c2 = i & 127;
            const float s = part[(0 * 8 + b) * 128 + c2] + part[(1 * 8 + b) * 128 + c2] + part[(2 * 8 + b) * 128 + c2] + part[(3 * 8 + b) * 128 + c2];
            mod[((size_t)l * 8 + b) * 6144 + cb * 128 + c2] = s + p.in[6][(size_t)l * 6144 + cb * 128 + c2];
        }
        __syncthreads();
    }
}

__device__ __forceinline__ void norm_phase(const float* src, const float* g, const float* modl, int sh_off, int sc_off, bf16_t* dst) {
    const int tid = otid(), wid = __builtin_amdgcn_readfirstlane(tid >> 6), lane = tid & 63;
    const int stride = ogrid() * 8;
    int row = obid() * 8 + wid;
    if (row >= T_) return;
    f32x4 gg[4];
#pragma unroll
    for (int j = 0; j < 4; ++j) gg[j] = *(const f32x4*)(g + lane * 4 + 256 * j);
    f32x4 vn[4];
#pragma unroll
    for (int j = 0; j < 4; ++j) vn[j] = *(const f32x4*)(src + (size_t)row * 1024 + lane * 4 + 256 * j);
    for (; row < T_; row += stride) {
        const int b = row >> 12;
        f32x4 v[4]; float ss = 0.f;
#pragma unroll
        for (int j = 0; j < 4; ++j) { v[j] = vn[j]; ss += v[j][0] * v[j][0] + v[j][1] * v[j][1] + v[j][2] * v[j][2] + v[j][3] * v[j][3]; }
        if (row + stride < T_) {
#pragma unroll
            for (int j = 0; j < 4; ++j) vn[j] = *(const f32x4*)(src + (size_t)(row + stride) * 1024 + lane * 4 + 256 * j);
        }
        ss = wave_sum(ss);
        const float rstd = rsqrtf(ss * (1.0f / 1024.0f) + 1e-6f);
#pragma unroll
        for (int j = 0; j < 4; ++j) {
            const int c = lane * 4 + 256 * j;
            const f32x4 sc = *(const f32x4*)(modl + (size_t)b * 6144 + sc_off + c);
            const f32x4 sh = *(const f32x4*)(modl + (size_t)b * 6144 + sh_off + c);
            float o[4];
#pragma unroll
            for (int e = 0; e < 4; ++e) o[e] = v[j][e] * rstd * gg[j][e] * (1.0f + sc[e]) + sh[e];
            u32x2 pk; pk.x = pk2(o[0], o[1]); pk.y = pk2(o[2], o[3]);
            *(u32x2*)(dst + (size_t)row * 1024 + c) = pk;
        }
    }
}
__device__ __forceinline__ void final_norm_phase(float* x, const float* g) {
    const int tid = otid(), wid = __builtin_amdgcn_readfirstlane(tid >> 6), lane = tid & 63;
    const int stride = ogrid() * 8;
    int row = obid() * 8 + wid;
    if (row >= T_) return;
    f32x4 gg[4];
#pragma unroll
    for (int j = 0; j < 4; ++j) gg[j] = *(const f32x4*)(g + lane * 4 + 256 * j);
    f32x4 vn[4];
#pragma unroll
    for (int j = 0; j < 4; ++j) vn[j] = *(const f32x4*)(x + (size_t)row * 1024 + lane * 4 + 256 * j);
    for (; row < T_; row += stride) {
        float* xr = x + (size_t)row * 1024;
        f32x4 v[4]; float ss = 0.f;
#pragma unroll
        for (int j = 0; j < 4; ++j) { v[j] = vn[j]; ss += v[j][0] * v[j][0] + v[j][1] * v[j][1] + v[j][2] * v[j][2] + v[j][3] * v[j][3]; }
        if (row + stride < T_) {
#pragma unroll
            for (int j = 0; j < 4; ++j) vn[j] = *(const f32x4*)(x + (size_t)(row + stride) * 1024 + lane * 4 + 256 * j);
        }
        ss = wave_sum(ss);
        const float rstd = rsqrtf(ss * (1.0f / 1024.0f) + 1e-6f);
#pragma unroll
        for (int j = 0; j < 4; ++j) { const int c = lane * 4 + 256 * j; *(f32x4*)(xr + c) = v[j] * rstd * gg[j]; }
    }
}

__device__ __forceinline__ float raw_at(const bf16_t* proj, const bf16_t* halo, int b, int n, int r, int col) {
    if (r >= 0) return bf2f(proj[((size_t)(b * SEQ + n * 64 + r)) * PC + col]);
    if (n == 0) return 0.f;
    return bf2f(halo[((size_t)(b * 64 + n - 1) * 3 + (r + 3)) * CONVC + col]);
}

__device__ __forceinline__ void gdn_prep(const Params& p, int l, int b, int n, int h, float* sm) {
    bf16_t* proj = (bf16_t*)(p.ws + WS_PROJ); const bf16_t* halo = (const bf16_t*)(p.ws + WS_HALO);
    bf16_t* wbuf = (bf16_t*)(p.ws + WS_M); bf16_t* abuf = (bf16_t*)(p.ws + WS_M + 33554432);
    float* Gc = (float*)(p.ws + WS_GC);
    float* Qs = sm; float* Ks = sm + 8448; float* Vs = sm + 16896; float* Am = sm + 25344; float* At = sm + 29696; float* gb = sm + 34048; float* bt = sm + 34112;
    bf16_t* Rq = (bf16_t*)Am; bf16_t* Rk = (bf16_t*)At; bf16_t* Rv = (bf16_t*)(sm + 34176);
    const int tid = otid(), wid = __builtin_amdgcn_readfirstlane(tid >> 6), lane = tid & 63, fr = lane & 15, kg = lane >> 4;
    const size_t tok0 = (size_t)b * SEQ + n * 64;
    const float* cw = p.in[8] + (size_t)l * 4 * CONVC; const float* cbv = p.in[9] + (size_t)l * CONVC;
    {
        const int nm1 = n > 0 ? n - 1 : 0;
        u32x4 sv[7];
#pragma unroll
        for (int q = 0; q < 7; ++q) {
            int idx = tid + 512 * q; idx = idx < 3216 ? idx : 3215;
            const int row = idx / 48, rem = idx % 48, which = rem >> 4, pc = rem & 15, r = row - 3, col = which * 512 + h * 128 + pc * 8;
            const bf16_t* ptr = (r >= 0) ? proj + (tok0 + r) * PC + col : halo + ((size_t)(b * 64 + nm1) * 3 + (r + 3)) * CONVC + col;
            sv[q] = *(const u32x4*)ptr;
        }
#pragma unroll
        for (int q = 0; q < 7; ++q) {
            const int idx = tid + 512 * q;
            if (idx < 3216) {
                const int row = idx / 48, rem = idx % 48, which = rem >> 4, pc = rem & 15, r = row - 3;
                u32x4 v = sv[q];
                if (r < 0 && n == 0) v = (u32x4){0u, 0u, 0u, 0u};
                *(u32x4*)((which == 0 ? Rq : which == 1 ? Rk : Rv) + row * 128 + pc * 8) = v;
            }
        }
    }
    if (tid < 64) {
        const float braw = bf2f(proj[(tok0 + tid) * PC + OBG + h]), araw = bf2f(proj[(tok0 + tid) * PC + OAG + h]);
        bt[tid] = sigmoidf_(braw);
        gb[tid] = -__expf(p.in[20][l * 4 + h]) * softplusf_(araw + p.in[21][l * 4 + h]);
    }
    __syncthreads();
    if (wid == 7) gb[lane] = wave_incl_scan(gb[lane], lane);
    if (tid < 384) {
        const int which = tid >> 7, d = tid & 127, col = which * 512 + h * 128 + d;
        const bf16_t* R = (which == 0 ? Rq : which == 1 ? Rk : Rv) + d;
        float* O = (which == 0 ? Qs : which == 1 ? Ks : Vs) + d;
        const float w0 = cw[col], w1 = cw[CONVC + col], w2 = cw[2 * CONVC + col], w3 = cw[3 * CONVC + col], bb = cbv[col];
        float x0 = bf2f(R[0]), x1 = bf2f(R[128]), x2 = bf2f(R[256]);
#pragma unroll 8
        for (int r = 0; r < 64; ++r) {
            const float x3 = bf2f(R[(r + 3) * 128]);
            O[r * 132] = siluf_(bb + w0 * x0 + w1 * x1 + w2 * x2 + w3 * x3);
            x0 = x1; x1 = x2; x2 = x3;
        }
    }
    __syncthreads();
    {
        float q0[8], q1[8], k0[8], k1[8], sq[8], sk[8];
#pragma unroll
        for (int i = 0; i < 8; ++i) {
            const int r = wid * 8 + i;
            q0[i] = Qs[r * 132 + lane]; q1[i] = Qs[r * 132 + 64 + lane]; k0[i] = Ks[r * 132 + lane]; k1[i] = Ks[r * 132 + 64 + lane];
            sq[i] = q0[i] * q0[i] + q1[i] * q1[i]; sk[i] = k0[i] * k0[i] + k1[i] * k1[i];
        }
#pragma unroll
        for (int o = 32; o > 0; o >>= 1)
#pragma unroll
            for (int i = 0; i < 8; ++i) { sq[i] += __shfl_xor(sq[i], o); sk[i] += __shfl_xor(sk[i], o); }
#pragma unroll
        for (int i = 0; i < 8; ++i) {
            const int r = wid * 8 + i;
            const float fq_ = rsqrtf(sq[i] + 1e-6f) * 0.08838834764831845f, fk_ = rsqrtf(sk[i] + 1e-6f);
            Qs[r * 132 + lane] = q0[i] * fq_; Qs[r * 132 + 64 + lane] = q1[i] * fq_; Ks[r * 132 + lane] = k0[i] * fk_; Ks[r * 132 + 64 + lane] = k1[i] * fk_;
        }
    }
    if (tid < 64) Gc[(tok0 + tid) * 4 + h] = gb[tid];
    __syncthreads();
#pragma unroll
    for (int tt = 0; tt < 2; ++tt) {
        const int t = wid * 2 + tt, it = t >> 2, jt = t & 3;
        f32x4 kk = (f32x4){0.f, 0.f, 0.f, 0.f}, qk = (f32x4){0.f, 0.f, 0.f, 0.f};
        if (jt <= it) {
#pragma unroll
            for (int ks = 0; ks < 4; ++ks) {
                const float* ka = Ks + (16 * it + fr) * 132 + 32 * ks + 8 * kg; const float* qa = Qs + (16 * it + fr) * 132 + 32 * ks + 8 * kg; const float* kb = Ks + (16 * jt + fr) * 132 + 32 * ks + 8 * kg;
                const bf16x8 fa = pack8(*(const f32x4*)ka, *(const f32x4*)(ka + 4)), fqa = pack8(*(const f32x4*)qa, *(const f32x4*)(qa + 4)), fb = pack8(*(const f32x4*)kb, *(const f32x4*)(kb + 4));
                kk = __builtin_amdgcn_mfma_f32_16x16x32_bf16(fa, fb, kk, 0, 0, 0);
                qk = __builtin_amdgcn_mfma_f32_16x16x32_bf16(fqa, fb, qk, 0, 0, 0);
            }
        }
        const int j = 16 * jt + fr; const float gj = gb[j];
#pragma unroll
        for (int r = 0; r < 4; ++r) {
            const int i = 16 * it + 4 * kg + r;
            const float dec = (j <= i) ? __expf(gb[i] - gj) : 0.f;
            Am[i * 68 + j] = (j < i) ? bt[i] * kk[r] * dec : 0.f;
            At[i * 68 + j] = qk[r] * dec;
        }
    }
    __syncthreads();
    {
        const float glast = gb[63];
#pragma unroll
        for (int q = 0; q < 2; ++q) {
            const int idx = tid + 512 * q;
            {
                const int i = idx >> 4, pq = idx & 15; const float eg = __expf(gb[i]);
                float v[8];
#pragma unroll
                for (int e = 0; e < 8; ++e) v[e] = Qs[i * 132 + iperm(pq * 8 + e)] * eg;
                u32x4 pk; pk.x = pk2(v[0], v[1]); pk.y = pk2(v[2], v[3]); pk.z = pk2(v[4], v[5]); pk.w = pk2(v[6], v[7]);
                *(u32x4*)(proj + (tok0 + i) * PC + OQ + h * 128 + pq * 8) = pk;
            }
            {
                const int d = idx & 127, pq = idx >> 7;
                float v[8];
#pragma unroll
                for (int e = 0; e < 8; ++e) { const int c = iperm(pq * 8 + e); v[e] = Ks[c * 132 + d] * __expf(glast - gb[c]); }
                u32x4 pk; pk.x = pk2(v[0], v[1]); pk.y = pk2(v[2], v[3]); pk.z = pk2(v[4], v[5]); pk.w = pk2(v[6], v[7]);
                *(u32x4*)(proj + (tok0 + (d >> 1)) * PC + OKK + h * 128 + (d & 1) * 64 + pq * 8) = pk;
            }
        }
        {
            const int i = tid >> 3, pq = tid & 7;
            float v[8];
#pragma unroll
            for (int e = 0; e < 8; ++e) v[e] = At[i * 68 + iperm(pq * 8 + e)];
            u32x4 pk; pk.x = pk2(v[0], v[1]); pk.y = pk2(v[2], v[3]); pk.z = pk2(v[4], v[5]); pk.w = pk2(v[6], v[7]);
            *(u32x4*)(abuf + (tok0 + i) * 256 + h * 64 + pq * 8) = pk;
        }
    }
    __syncthreads();
    for (int idx = tid; idx < 64 * 128; idx += 512) {
        const int i = idx >> 7, d = idx & 127;
        Ks[i * 132 + d] *= bt[i] * __expf(gb[i]);
        Vs[i * 132 + d] *= bt[i];
    }
    __syncthreads();
    if (tid < 256) {
        const int which = tid >> 7, d = tid & 127;
        float* rhs = (which == 0 ? Ks : Vs) + d;
        float s[64];
#pragma unroll
        for (int i = 0; i < 64; ++i) {
            float a = rhs[i * 132];
#pragma unroll
            for (int j4 = 0; j4 < (i + 3) / 4; ++j4) {
                const f32x4 av = *(const f32x4*)(Am + i * 68 + j4 * 4);
#pragma unroll
                for (int e = 0; e < 4; ++e) if (j4 * 4 + e < i) a -= av[e] * s[j4 * 4 + e];
            }
            s[i] = a;
        }
        if (which == 0) {
#pragma unroll
            for (int i = 0; i < 64; ++i) rhs[i * 132] = s[i];
        } else {
            bf16_t* up = proj + (tok0 + (d >> 1)) * PC + OV + h * 128 + (d & 1) * 64;
#pragma unroll
            for (int q = 0; q < 8; ++q) { u32x4 pk; pk.x = pk2(s[q * 8], s[q * 8 + 1]); pk.y = pk2(s[q * 8 + 2], s[q * 8 + 3]); pk.z = pk2(s[q * 8 + 4], s[q * 8 + 5]); pk.w = pk2(s[q * 8 + 6], s[q * 8 + 7]); *(u32x4*)(up + q * 8) = pk; }
        }
    }
    __syncthreads();
#pragma unroll
    for (int q = 0; q < 2; ++q) {
        const int idx = tid + 512 * q, i = idx >> 4, pq = idx & 15;
        float v[8];
#pragma unroll
        for (int e = 0; e < 8; ++e) v[e] = Ks[i * 132 + iperm(pq * 8 + e)];
        u32x4 pk; pk.x = pk2(v[0], v[1]); pk.y = pk2(v[2], v[3]); pk.z = pk2(v[4], v[5]); pk.w = pk2(v[6], v[7]);
        *(u32x4*)(wbuf + (tok0 + i) * 512 + h * 128 + pq * 8) = pk;
    }
    __syncthreads();
}

__device__ __forceinline__ void ssd_prep(const Params& p, int l, int b, int n, float* sm) {
    bf16_t* proj = (bf16_t*)(p.ws + WS_PROJ); const bf16_t* halo = (const bf16_t*)(p.ws + WS_HALO);
    bf16_t* cbbuf = (bf16_t*)(p.ws + WS_M + 50331648);
    float* dtb = (float*)(p.ws + WS_DT); float* csb = (float*)(p.ws + WS_CS);
    const int tid = otid();
    const size_t tok0 = (size_t)b * SEQ + n * 64;
    const float* cw = p.in[8] + (size_t)l * 4 * CONVC; const float* cbv = p.in[9] + (size_t)l * CONVC;
    bf16_t* Lt = (bf16_t*)sm;
    float* la = sm + 26000;
    {
        const int nm1 = n > 0 ? n - 1 : 0;
        u32x4 sv[13];
#pragma unroll
        for (int q = 0; q < 13; ++q) {
            int idx = tid + 512 * q; idx = idx < 6432 ? idx : 6431;
            const int row = idx / 96, pc = idx % 96, r = row - 3, col = OXS + pc * 8;
            const bf16_t* ptr = (r >= 0) ? proj + (tok0 + r) * PC + col : halo + ((size_t)(b * 64 + nm1) * 3 + (r + 3)) * CONVC + col;
            sv[q] = *(const u32x4*)ptr;
        }
#pragma unroll
        for (int q = 0; q < 13; ++q) {
            const int idx = tid + 512 * q;
            if (idx < 6432) {
                const int row = idx / 96, pc = idx % 96, r = row - 3;
                u32x4 v = sv[q];
                if (r < 0 && n == 0) v = (u32x4){0u, 0u, 0u, 0u};
                *(u32x4*)(Lt + row * 776 + pc * 8) = v;
            }
        }
    }
    __syncthreads();
    for (int c = tid; c < 768; c += 512) {
        const int col = OXS + c;
        const float w0 = cw[col], w1 = cw[CONVC + col], w2 = cw[2 * CONVC + col], w3 = cw[3 * CONVC + col], bb = cbv[col];
        float x0 = bf2f(Lt[c]), x1 = bf2f(Lt[776 + c]), x2 = bf2f(Lt[2 * 776 + c]);
#pragma unroll 8
        for (int r = 0; r < 64; ++r) {
            const float x3 = bf2f(Lt[(r + 3) * 776 + c]);
            Lt[r * 776 + c] = f2bf(siluf_(bb + w0 * x0 + w1 * x1 + w2 * x2 + w3 * x3));
            x0 = x1; x1 = x2; x2 = x3;
        }
    }
    {
        const int r = tid >> 3, j = tid & 7;
        const float dt = softplusf_(bf2f(proj[(tok0 + r) * PC + ODT + j]) + p.in[24][l * 8 + j]);
        dtb[(tok0 + r) * 8 + j] = dt;
        la[r * 8 + j] = -__expf(p.in[23][l * 8 + j]) * dt;
    }
    __syncthreads();
    { const int wv = __builtin_amdgcn_readfirstlane(tid >> 6), ln = tid & 63; csb[(tok0 + ln) * 8 + wv] = wave_incl_scan(la[ln * 8 + wv], ln); }
    {
        bf16_t* dst = proj + (tok0 + (tid & 63)) * PC + OXS + (tid >> 6) * 64;
#pragma unroll
        for (int q = 0; q < 8; ++q) {
            u32x4 pk;
            pk.x = (unsigned)Lt[(q * 8 + 0) * 776 + tid] | ((unsigned)Lt[(q * 8 + 1) * 776 + tid] << 16); pk.y = (unsigned)Lt[(q * 8 + 2) * 776 + tid] | ((unsigned)Lt[(q * 8 + 3) * 776 + tid] << 16);
            pk.z = (unsigned)Lt[(q * 8 + 4) * 776 + tid] | ((unsigned)Lt[(q * 8 + 5) * 776 + tid] << 16); pk.w = (unsigned)Lt[(q * 8 + 6) * 776 + tid] | ((unsigned)Lt[(q * 8 + 7) * 776 + tid] << 16);
            *(u32x4*)(dst + q * 8) = pk;
        }
    }
    if (tid < 128) {
        bf16_t* dst = proj + (tok0 + (tid & 63)) * PC + OBS + (tid >> 6) * 64;
        const int c = 512 + tid;
#pragma unroll
        for (int q = 0; q < 8; ++q) {
            u32x4 pk;
            pk.x = (unsigned)Lt[(q * 8 + 0) * 776 + c] | ((unsigned)Lt[(q * 8 + 1) * 776 + c] << 16); pk.y = (unsigned)Lt[(q * 8 + 2) * 776 + c] | ((unsigned)Lt[(q * 8 + 3) * 776 + c] << 16);
            pk.z = (unsigned)Lt[(q * 8 + 4) * 776 + c] | ((unsigned)Lt[(q * 8 + 5) * 776 + c] << 16); pk.w = (unsigned)Lt[(q * 8 + 6) * 776 + c] | ((unsigned)Lt[(q * 8 + 7) * 776 + c] << 16);
            *(u32x4*)(dst + q * 8) = pk;
        }
    } else if (tid < 256) {
        const int lrow = tid & 63, g = (tid >> 6) & 1;
        bf16_t* dst = proj + (tok0 + lrow) * PC + OCS + g * 64;
        const bf16_t* src = Lt + lrow * 776 + 640 + g * 64;
#pragma unroll
        for (int q = 0; q < 8; ++q) {
            u32x4 pk;
            pk.x = (unsigned)src[iperm(q * 8 + 0)] | ((unsigned)src[iperm(q * 8 + 1)] << 16); pk.y = (unsigned)src[iperm(q * 8 + 2)] | ((unsigned)src[iperm(q * 8 + 3)] << 16);
            pk.z = (unsigned)src[iperm(q * 8 + 4)] | ((unsigned)src[iperm(q * 8 + 5)] << 16); pk.w = (unsigned)src[iperm(q * 8 + 6)] | ((unsigned)src[iperm(q * 8 + 7)] << 16);
            *(u32x4*)(dst + q * 8) = pk;
        }
    }
    {
        const int lrow = tid >> 3, mg = tid & 7;
#pragma unroll 1
        for (int g = 0; g < 2; ++g) {
            float cb[8];
#pragma unroll
            for (int mm = 0; mm < 8; ++mm) cb[mm] = 0.f;
            const bf16_t* cp = Lt + lrow * 776 + 640 + g * 64;
#pragma unroll 4
            for (int q = 0; q < 64; q += 2) {
                const unsigned cu = *(const unsigned*)(cp + q);
                const float c0 = __uint_as_float(cu << 16), c1 = __uint_as_float(cu & 0xffff0000u);
#pragma unroll
                for (int mm = 0; mm < 8; ++mm) { const unsigned bu = *(const unsigned*)(Lt + (mg + 8 * mm) * 776 + 512 + g * 64 + q); cb[mm] += c0 * __uint_as_float(bu << 16) + c1 * __uint_as_float(bu & 0xffff0000u); }
            }
#pragma unroll
            for (int mm = 0; mm < 8; ++mm) cbbuf[(tok0 + lrow) * 128 + g * 64 + mg + 8 * mm] = f2bf(cb[mm]);
        }
    }
    __syncthreads();
}

template <int MODE>
__device__ __forceinline__ void lru_chunk(const Params& p, int l, int b, int n, float* sm) {
    bf16_t* proj = (bf16_t*)(p.ws + WS_PROJ); const bf16_t* halo = (const bf16_t*)(p.ws + WS_HALO);
    float* LA = (float*)(p.ws + WS_LA); float* LH = (float*)(p.ws + WS_LH);
    const bf16_t* Wt = (const bf16_t*)(p.ws + WS_PAR + 294912);
    const int tid = otid(), wid = __builtin_amdgcn_readfirstlane(tid >> 6), lane = tid & 63, fr = lane & 15, kg = lane >> 4;
    const int nb = wid, ch = nb * 64 + lane, col = OXL + ch;
    unsigned char* wbase = (unsigned char*)sm + wid * 18432;
    bf16_t* xb = (bf16_t*)wbase;
    float* pre = (float*)(wbase + 9728);
    const size_t tok0 = (size_t)b * SEQ + n * 64;
    const float* cw = p.in[8] + (size_t)l * 4 * CONVC; const float* cbv = p.in[9] + (size_t)l * CONVC;
    {
        const int nm1 = n > 0 ? n - 1 : 0;
        u32x4 sv[9];
#pragma unroll
        for (int q = 0; q < 9; ++q) {
            int idx = lane + 64 * q; idx = idx < 536 ? idx : 535;
            const int row = idx >> 3, pc = idx & 7, r = row - 3, c8 = OXL + nb * 64 + pc * 8;
            const bf16_t* ptr = (r >= 0) ? proj + (tok0 + r) * PC + c8 : halo + ((size_t)(b * 64 + nm1) * 3 + (r + 3)) * CONVC + c8;
            sv[q] = *(const u32x4*)ptr;
        }
#pragma unroll
        for (int q = 0; q < 9; ++q) {
            const int idx = lane + 64 * q;
            if (idx < 536) {
                const int row = idx >> 3, pc = idx & 7, r = row - 3;
                u32x4 v = sv[q];
                if (r < 0 && n == 0) v = (u32x4){0u, 0u, 0u, 0u};
                *(u32x4*)(xb + row * 72 + pc * 8) = v;
            }
        }
    }
    bf16x8 Wf[2][4][2];
#pragma unroll
    for (int gs = 0; gs < 2; ++gs)
#pragma unroll
        for (int et = 0; et < 4; ++et)
#pragma unroll
            for (int ks = 0; ks < 2; ++ks) Wf[gs][et][ks] = *(const bf16x8*)(Wt + ((size_t)((gs * 8 + nb) * 64 + 16 * et + fr)) * 64 + 32 * ks + 8 * kg);
    asm volatile("s_waitcnt lgkmcnt(0)" ::: "memory");
    {
        const float w0 = cw[col], w1 = cw[CONVC + col], w2 = cw[2 * CONVC + col], w3 = cw[3 * CONVC + col], bb = cbv[col];
        float x0 = bf2f(xb[lane]), x1 = bf2f(xb[72 + lane]), x2 = bf2f(xb[144 + lane]);
#pragma unroll 8
        for (int r = 0; r < 64; ++r) {
            const float x3 = bf2f(xb[(r + 3) * 72 + lane]);
            xb[r * 72 + lane] = f2bf(bb + w0 * x0 + w1 * x1 + w2 * x2 + w3 * x3);
            x0 = x1; x1 = x2; x2 = x3;
        }
    }
    asm volatile("s_waitcnt lgkmcnt(0)" ::: "memory");
    const float sp = 8.0f * softplusf_(-p.in[27][l * 512 + ch]);
    const float br_ = p.in[29][l * 512 + ch], bi_ = p.in[31][l * 512 + ch];
    const size_t ci = ((size_t)b * 64 + n) * 512 + ch;
    float H = (MODE == 1) ? LH[ci] : 0.f, A = 1.f;
#pragma unroll 1
    for (int q = 0; q < 4; ++q) {
        bf16_t gq[16];
        if (MODE == 1) {
#pragma unroll
            for (int t = 0; t < 16; ++t) gq[t] = proj[(tok0 + 16 * q + t) * PC + OGL + ch];
        }
        bf16x8 af[2];
#pragma unroll
        for (int ks = 0; ks < 2; ++ks) af[ks] = *(const bf16x8*)(xb + (16 * q + fr) * 72 + 32 * ks + 8 * kg);
#pragma unroll
        for (int gs = 0; gs < 2; ++gs)
#pragma unroll
            for (int et = 0; et < 4; ++et) {
                f32x4 acc = (f32x4){0.f, 0.f, 0.f, 0.f};
                acc = __builtin_amdgcn_mfma_f32_16x16x32_bf16(af[0], Wf[gs][et][0], acc, 0, 0, 0);
                acc = __builtin_amdgcn_mfma_f32_16x16x32_bf16(af[1], Wf[gs][et][1], acc, 0, 0, 0);
#pragma unroll
                for (int r = 0; r < 4; ++r) pre[(4 * kg + r) * 132 + gs * 64 + 16 * et + fr] = acc[r];
            }
        asm volatile("s_waitcnt lgkmcnt(0)" ::: "memory");
#pragma unroll
        for (int t = 0; t < 16; ++t) {
            const int r = 16 * q + t;
            const float rg = sigmoidf_(pre[t * 132 + lane] + br_), ig = sigmoidf_(pre[t * 132 + 64 + lane] + bi_);
            const float log_a = -sp * rg;
            const float a = __expf(log_a);
            float mult = __builtin_amdgcn_sqrtf(fmaxf(1.0f - a * a, 0.f));
            if (n == 0 && r == 0) mult = 1.0f;
            H = a * H + mult * ig * bf2f(xb[r * 72 + lane]);
            if (MODE == 0) A *= a;
            else {
                const float gt = bf2f(gq[t]);
                proj[(tok0 + r) * PC + col] = f2bf(H * geluf_(gt));
            }
        }
        asm volatile("s_waitcnt lgkmcnt(0)" ::: "memory");
    }
    if (MODE == 0) { LA[ci] = A; LH[ci] = H; }
    __syncthreads();
}

__device__ __forceinline__ void s5_consts(const Params& p, int l, int g, int pp, float& lr, float& li, float (&Br)[16], float (&Bi)[16]) {
    const int gp = (l * 24 + g) * 64 + pp;
    const float re = p.in[10][gp], im = p.in[11][gp], dt = __expf(p.in[12][l * 24 + g]);
    const float a = re * dt, th = im * dt;
    const float ea = __expf(a), cs = cosf(th), sn = sinf(th);
    lr = ea * cs; li = ea * sn;
    const float sh = sinf(0.5f * th);
    const float mr = expm1f(a) * cs - 2.0f * sh * sh, mi = li;
    const float den = 1.0f / (re * re + im * im);
    const float fr_ = (mr * re + mi * im) * den, fi_ = (mi * re - mr * im) * den;
#pragma unroll
    for (int h = 0; h < 16; ++h) {
        const float br = p.in[13][(size_t)gp * 16 + h], bi = p.in[14][(size_t)gp * 16 + h];
        Br[h] = fr_ * br - fi_ * bi; Bi[h] = fr_ * bi + fi_ * br;
    }
}
template <int MODE>
__device__ __forceinline__ void s5_chunk(const Params& p, int l, int b, int n, float* sm) {
    bf16_t* proj = (bf16_t*)(p.ws + WS_PROJ);
    float* S5C = (float*)(p.ws + WS_S5C);
    const bf16_t* gluT = (const bf16_t*)(p.ws + WS_PAR);
    float* us = sm;
    const int tid = otid(), wid = __builtin_amdgcn_readfirstlane(tid >> 6), lane = tid & 63, fr = lane & 15, kg = lane >> 4;
    bf16_t* xw = (bf16_t*)(sm + 24832) + wid * 2048;
    const size_t tok0 = (size_t)b * SEQ + n * 64;
#pragma unroll
    for (int q = 0; q < 6; ++q) {
        const int idx = tid + 512 * q, r = idx / 48, pc = idx % 48;
        const u32x4 v = *(const u32x4*)(proj + (tok0 + r) * PC + OU5 + pc * 8);
        *(f32x4*)(us + r * 388 + pc * 8) = up4((u32x2){v.x, v.y}); *(f32x4*)(us + r * 388 + pc * 8 + 4) = up4((u32x2){v.z, v.w});
    }
    __syncthreads();
    for (int g = wid; g < 24; g += 8) {
        float lr, li, Br[16], Bi[16];
        s5_consts(p, l, g, lane, lr, li, Br, Bi);
        f32x2 B2[16];
#pragma unroll
        for (int h = 0; h < 16; ++h) { B2[h].x = Br[h]; B2[h].y = Bi[h]; }
        float Xr = 0.f, Xi = 0.f;
        const size_t cidx = ((((size_t)b * 64 + n) * 24 + g) * 64 + lane) * 2;
        bf16x8 Cf[4];
        if (MODE == 1) {
            Xr = S5C[cidx]; Xi = S5C[cidx + 1];
            const float* crp = p.in[15] + ((size_t)(l * 24 + g) * 16 + fr) * 64; const float* cip = p.in[16] + ((size_t)(l * 24 + g) * 16 + fr) * 64;
#pragma unroll
            for (int ks = 0; ks < 4; ++ks) {
                const f32x4 cr = *(const f32x4*)(crp + 16 * ks + 4 * kg), ci = *(const f32x4*)(cip + 16 * ks + 4 * kg);
                Cf[ks] = pack8((f32x4){cr[0], -ci[0], cr[1], -ci[1]}, (f32x4){cr[2], -ci[2], cr[3], -ci[3]});
            }
        }
#pragma unroll 1
        for (int sb = 0; sb < 4; ++sb) {
#pragma unroll 4
            for (int ss = 0; ss < 16; ++ss) {
                const int s = sb * 16 + ss;
                f32x2 bu = {0.f, 0.f};
#pragma unroll
                for (int h4 = 0; h4 < 4; ++h4) {
                    const f32x4 u = *(const f32x4*)(us + s * 388 + g * 16 + h4 * 4);
                    bu += B2[h4 * 4 + 0] * u[0]; bu += B2[h4 * 4 + 1] * u[1]; bu += B2[h4 * 4 + 2] * u[2]; bu += B2[h4 * 4 + 3] * u[3];
                }
                const float nr = lr * Xr - li * Xi + bu.x, ni = lr * Xi + li * Xr + bu.y;
                Xr = nr; Xi = ni;
                if (MODE == 1) *(unsigned*)(xw + ss * 128 + 2 * lane) = pk2(Xr, Xi);
            }
            if (MODE == 1) {
                asm volatile("s_waitcnt lgkmcnt(0)" ::: "memory");
                f32x4 acc = (f32x4){0.f, 0.f, 0.f, 0.f};
                bf16x8 af[4];
#pragma unroll
                for (int ks = 0; ks < 4; ++ks) af[ks] = *(const bf16x8*)(xw + fr * 128 + 32 * ks + 8 * kg);
                asm volatile("s_waitcnt lgkmcnt(0)" ::: "memory");
#pragma unroll
                for (int ks = 0; ks < 4; ++ks) acc = __builtin_amdgcn_mfma_f32_16x16x32_bf16(af[ks], Cf[ks], acc, 0, 0, 0);
                const int c = g * 16 + fr; const float dd = p.in[17][l * 384 + c];
#pragma unroll
                for (int r = 0; r < 4; ++r) { const int s = sb * 16 + 4 * kg + r; us[s * 388 + c] = geluf_(acc[r] + dd * us[s * 388 + c]); }
            }
        }
        if (MODE == 0) { S5C[cidx] = Xr; S5C[cidx + 1] = Xi; }
    }
    __syncthreads();
    if (MODE == 1) {
        f32x4 acc[3][4];
#pragma unroll
        for (int a = 0; a < 3; ++a)
#pragma unroll
            for (int m = 0; m < 4; ++m) acc[a][m] = (f32x4){0.f, 0.f, 0.f, 0.f};
#pragma unroll 1
        for (int ks = 0; ks < 12; ++ks) {
            bf16x8 af[4];
#pragma unroll
            for (int m = 0; m < 4; ++m) { const float* ap = us + (16 * m + fr) * 388 + 32 * ks + 8 * kg; af[m] = pack8(*(const f32x4*)ap, *(const f32x4*)(ap + 4)); }
#pragma unroll
            for (int a = 0; a < 3; ++a) {
                const bf16x8 bfr = *(const bf16x8*)(gluT + (size_t)(16 * (wid * 3 + a) + fr) * 384 + 32 * ks + 8 * kg);
#pragma unroll
                for (int m = 0; m < 4; ++m) acc[a][m] = __builtin_amdgcn_mfma_f32_16x16x32_bf16(af[m], bfr, acc[a][m], 0, 0, 0);
            }
        }
        __syncthreads();
#pragma unroll
        for (int a = 0; a < 3; ++a) {
            const int j = 16 * (wid * 3 + a) + fr; const float gbias = p.in[19][l * 384 + j];
#pragma unroll
            for (int m = 0; m < 4; ++m)
#pragma unroll
                for (int r = 0; r < 4; ++r) { const int s = 16 * m + 4 * kg + r; us[s * 388 + j] *= sigmoidf_(acc[a][m][r] + gbias); }
        }
        __syncthreads();
#pragma unroll
        for (int q = 0; q < 6; ++q) {
            const int idx = tid + 512 * q, r = idx / 48, pc = idx % 48;
            const f32x4 a = *(const f32x4*)(us + r * 388 + pc * 8), c = *(const f32x4*)(us + r * 388 + pc * 8 + 4);
            u32x4 pk; pk.x = pk2(a[0], a[1]); pk.y = pk2(a[2], a[3]); pk.z = pk2(c[0], c[1]); pk.w = pk2(c[2], c[3]);
            *(u32x4*)(proj + (tok0 + r) * PC + OU5 + pc * 8) = pk;
        }
        __syncthreads();
    }
}

#define MFMA16(a, b, c) __builtin_amdgcn_mfma_f32_16x16x32_bf16((a), (b), (c), 0, 0, 0)
__device__ __forceinline__ void gdn_seq(const Params& p, int b, int h, int half, float* sm) {
    bf16_t* proj = (bf16_t*)(p.ws + WS_PROJ);
    const bf16_t* wbuf = (const bf16_t*)(p.ws + WS_M); const bf16_t* abuf = (const bf16_t*)(p.ws + WS_M + 33554432);
    const float* Gc = (const float*)(p.ws + WS_GC);
    unsigned char* L = (unsigned char*)sm;
    constexpr int OW = 0, OQL = 17408, OA = 34816, OKT = 44032, BUF = 62464;
    const int tid = otid(), wid = __builtin_amdgcn_readfirstlane(tid >> 6), lane = tid & 63, fr = lane & 15, kg = lane >> 4;
    const int e = (half * 4 + (wid & 3)) * 16 + fr;
    const bool cw_ = wid < 4;
    const size_t tokb = (size_t)b * SEQ;
    const int r16 = tid >> 4, pc16 = tid & 15, r8 = tid >> 3, pc8 = tid & 7;
    u32x4 gW[2], gQ[2], gA, gK[2]; u32x2 gU[4];
    auto issue = [&](int n) {
        const size_t tok0 = tokb + (size_t)n * 64;
#pragma unroll
        for (int q = 0; q < 2; ++q) {
            const int row = r16 + 32 * q;
            gW[q] = *(const u32x4*)(wbuf + (tok0 + row) * 512 + h * 128 + pc16 * 8);
            gQ[q] = *(const u32x4*)(proj + (tok0 + row) * PC + OQ + h * 128 + pc16 * 8);
            gK[q] = *(const u32x4*)(proj + (tok0 + row) * PC + OKK + h * 128 + pc16 * 8);
        }
        gA = *(const u32x4*)(abuf + (tok0 + r8) * 256 + h * 64 + pc8 * 8);
#pragma unroll
        for (int ct = 0; ct < 4; ++ct) gU[ct] = *(const u32x2*)(proj + (tok0 + (e >> 1)) * PC + OV + h * 128 + (e & 1) * 64 + 16 * ct + 4 * kg);
    };
    auto commit = [&](int buf) {
        unsigned char* B = L + buf * BUF;
#pragma unroll
        for (int q = 0; q < 2; ++q) {
            const int row = r16 + 32 * q;
            *(u32x4*)(B + OW + row * 272 + pc16 * 16) = gW[q];
            *(u32x4*)(B + OQL + row * 272 + pc16 * 16) = gQ[q];
            *(u32x4*)(B + OKT + (2 * row + (pc16 >> 3)) * 144 + (pc16 & 7) * 16) = gK[q];
        }
        *(u32x4*)(B + OA + r8 * 144 + pc8 * 16) = gA;
    };
    f32x4 S[8];
#pragma unroll
    for (int i = 0; i < 8; ++i) S[i] = (f32x4){0.f, 0.f, 0.f, 0.f};
    issue(0); commit(0);
    f32x4 U[4];
#pragma unroll
    for (int ct = 0; ct < 4; ++ct) U[ct] = up4(gU[ct]);
    __syncthreads();
#pragma unroll 1
    for (int n = 0; n < 64; ++n) {
        const unsigned char* B = L + (n & 1) * BUF;
        const size_t tok0 = tokb + (size_t)n * 64;
        if (n + 1 < 64) issue(n + 1);
        if (cw_) {
        const float gl = __expf(Gc[(tok0 + 63) * 4 + h]);
        bf16x8 Sf[4];
#pragma unroll
        for (int s4 = 0; s4 < 4; ++s4) Sf[s4] = pack8(S[2 * s4], S[2 * s4 + 1]);
        f32x4 V[4], O[4];
#pragma unroll
        for (int ct = 0; ct < 4; ++ct) {
            f32x4 t = (f32x4){0.f, 0.f, 0.f, 0.f}, o = (f32x4){0.f, 0.f, 0.f, 0.f};
#pragma unroll
            for (int s4 = 0; s4 < 4; ++s4) {
                const bf16x8 wf = *(const bf16x8*)(B + OW + (16 * ct + fr) * 272 + (32 * s4 + 8 * kg) * 2);
                const bf16x8 qf = *(const bf16x8*)(B + OQL + (16 * ct + fr) * 272 + (32 * s4 + 8 * kg) * 2);
                t = MFMA16(wf, Sf[s4], t); o = MFMA16(qf, Sf[s4], o);
            }
            V[ct] = U[ct] - t; O[ct] = o;
        }
        bf16x8 Vf[2];
        Vf[0] = pack8(V[0], V[1]); Vf[1] = pack8(V[2], V[3]);
#pragma unroll
        for (int ct = 0; ct < 4; ++ct) {
#pragma unroll
            for (int s2 = 0; s2 < 2; ++s2) {
                const bf16x8 af = *(const bf16x8*)(B + OA + (16 * ct + fr) * 144 + (32 * s2 + 8 * kg) * 2);
                O[ct] = MFMA16(af, Vf[s2], O[ct]);
            }
            u32x2 pk; pk.x = pk2(O[ct][0], O[ct][1]); pk.y = pk2(O[ct][2], O[ct][3]);
            *(u32x2*)(proj + (tok0 + (e >> 1)) * PC + OV + h * 128 + (e & 1) * 64 + 16 * ct + 4 * kg) = pk;
        }
#pragma unroll
        for (int dt = 0; dt < 8; ++dt) {
            f32x4 a = S[dt] * gl;
#pragma unroll
            for (int s2 = 0; s2 < 2; ++s2) {
                const bf16x8 kf = *(const bf16x8*)(B + OKT + (16 * dt + fr) * 144 + (32 * s2 + 8 * kg) * 2);
                a = MFMA16(kf, Vf[s2], a);
            }
            S[dt] = a;
        }
        }
        if (n + 1 < 64) {
            commit((n + 1) & 1);
#pragma unroll
            for (int ct = 0; ct < 4; ++ct) U[ct] = up4(gU[ct]);
        }
        __syncthreads();
    }
}

__device__ __forceinline__ void ssd_seq(const Params& p, int l, int b, int j, float* sm) {
    bf16_t* proj = (bf16_t*)(p.ws + WS_PROJ);
    const bf16_t* cbbuf = (const bf16_t*)(p.ws + WS_M + 50331648);
    const float* dtb = (const float*)(p.ws + WS_DT); const float* csb = (const float*)(p.ws + WS_CS);
    unsigned char* L = (unsigned char*)sm;
    constexpr int OCB = 0, OC = 9216, OBT = 18432, ODTL = 27648, OCSL = 27904, BUF = 28160;
    const int tid = otid(), wid = __builtin_amdgcn_readfirstlane(tid >> 6), lane = tid & 63, fr = lane & 15, kg = lane >> 4, g = j >> 2;
    const float dsk = p.in[25][l * 8 + j];
    const size_t tokb = (size_t)b * SEQ;
    const int r8 = tid >> 3, pc8 = tid & 7;
    const int pch = (wid & 3) * 16 + fr;
    u32x4 gCB, gC, gBT, gX[2]; u32x2 gXs[4]; float gv = 0.f;
    auto issue = [&](int n) {
        const size_t tok0 = tokb + (size_t)n * 64;
        gCB = *(const u32x4*)(cbbuf + (tok0 + r8) * 128 + g * 64 + pc8 * 8);
        gC = *(const u32x4*)(proj + (tok0 + r8) * PC + OCS + g * 64 + pc8 * 8);
        gBT = *(const u32x4*)(proj + (tok0 + r8) * PC + OBS + g * 64 + pc8 * 8);
        if (tid < 64) gv = dtb[(tok0 + tid) * 8 + j]; else if (tid < 128) gv = csb[(tok0 + tid - 64) * 8 + j];
        if (wid < 4) {
            const bf16_t* xp = proj + (tok0 + pch) * PC + OXS + j * 64;
#pragma unroll
            for (int s2 = 0; s2 < 2; ++s2) gX[s2] = *(const u32x4*)(xp + 32 * s2 + 8 * kg);
#pragma unroll
            for (int lt = 0; lt < 4; ++lt) gXs[lt] = *(const u32x2*)(xp + 16 * lt + 4 * kg);
        }
    };
    auto commit = [&](int buf) {
        unsigned char* B = L + buf * BUF;
        *(u32x4*)(B + OCB + r8 * 144 + pc8 * 16) = gCB;
        *(u32x4*)(B + OC + r8 * 144 + pc8 * 16) = gC;
        *(u32x4*)(B + OBT + r8 * 144 + pc8 * 16) = gBT;
        if (tid < 64) *(float*)(B + ODTL + tid * 4) = gv; else if (tid < 128) *(float*)(B + OCSL + (tid - 64) * 4) = gv;
    };
    f32x4 St[4];
#pragma unroll
    for (int i = 0; i < 4; ++i) St[i] = (f32x4){0.f, 0.f, 0.f, 0.f};
    issue(0); commit(0);
    u32x4 cX[2]; u32x2 cXs[4];
#pragma unroll
    for (int i = 0; i < 2; ++i) cX[i] = gX[i];
#pragma unroll
    for (int i = 0; i < 4; ++i) cXs[i] = gXs[i];
    __syncthreads();
#pragma unroll 1
    for (int n = 0; n < 64; ++n) {
        const unsigned char* B = L + (n & 1) * BUF;
        const size_t tok0 = tokb + (size_t)n * 64;
        if (n + 1 < 64) issue(n + 1);
        if (wid < 4) {
            const float* dtl = (const float*)(B + ODTL); const float* csl = (const float*)(B + OCSL);
            const float cend = csl[63];
            bf16x8 Xd[2], Xf[2];
#pragma unroll
            for (int s2 = 0; s2 < 2; ++s2) {
                const f32x4 xa = up4((u32x2){cX[s2].x, cX[s2].y}), xb = up4((u32x2){cX[s2].z, cX[s2].w});
                f32x4 da, db, fa, fb;
#pragma unroll
                for (int i = 0; i < 4; ++i) {
                    const int m0 = 32 * s2 + 8 * kg + i, m1 = m0 + 4;
                    da[i] = xa[i] * dtl[m0]; db[i] = xb[i] * dtl[m1];
                    fa[i] = da[i] * __expf(cend - csl[m0]); fb[i] = db[i] * __expf(cend - csl[m1]);
                }
                Xd[s2] = pack8(da, db); Xf[s2] = pack8(fa, fb);
            }
            bf16x8 Sb[2];
            Sb[0] = pack8(St[0], St[1]); Sb[1] = pack8(St[2], St[3]);
#pragma unroll
            for (int lt = 0; lt < 4; ++lt) {
                f32x4 y = (f32x4){0.f, 0.f, 0.f, 0.f};
#pragma unroll
                for (int s2 = 0; s2 < 2; ++s2) { const bf16x8 cf = *(const bf16x8*)(B + OC + (16 * lt + fr) * 144 + (32 * s2 + 8 * kg) * 2); y = MFMA16(cf, Sb[s2], y); }
#pragma unroll
                for (int r = 0; r < 4; ++r) y[r] *= __expf(csl[16 * lt + 4 * kg + r]);
                const int lrow = 16 * lt + fr; const float cl_ = csl[lrow];
#pragma unroll
                for (int s2 = 0; s2 < 2; ++s2) {
                    if (32 * s2 <= 16 * lt + 15) {
                        const u32x4 raw = *(const u32x4*)(B + OCB + lrow * 144 + (32 * s2 + 8 * kg) * 2);
                        const f32x4 ca = up4((u32x2){raw.x, raw.y}), cb = up4((u32x2){raw.z, raw.w});
                        f32x4 ea, eb;
#pragma unroll
                        for (int i = 0; i < 4; ++i) {
                            const int m0 = 32 * s2 + 8 * kg + i, m1 = m0 + 4;
                            ea[i] = (m0 <= lrow) ? ca[i] * __expf(cl_ - csl[m0]) : 0.f;
                            eb[i] = (m1 <= lrow) ? cb[i] * __expf(cl_ - csl[m1]) : 0.f;
                        }
                        y = MFMA16(pack8(ea, eb), Xd[s2], y);
                    }
                }
                const f32x4 xs = up4(cXs[lt]);
                y = y + xs * dsk;
                u32x2 pk; pk.x = pk2(y[0], y[1]); pk.y = pk2(y[2], y[3]);
                *(u32x2*)(proj + (tok0 + pch) * PC + OXS + j * 64 + 16 * lt + 4 * kg) = pk;
            }
            const float ee = __expf(cend);
#pragma unroll
            for (int nt = 0; nt < 4; ++nt) {
                f32x4 a = St[nt] * ee;
#pragma unroll
                for (int s2 = 0; s2 < 2; ++s2) { const bf16x8 bf = *(const bf16x8*)(B + OBT + (16 * nt + fr) * 144 + (32 * s2 + 8 * kg) * 2); a = MFMA16(bf, Xf[s2], a); }
                St[nt] = a;
            }
        }
        if (n + 1 < 64) {
            commit((n + 1) & 1);
#pragma unroll
            for (int i = 0; i < 2; ++i) cX[i] = gX[i];
#pragma unroll
            for (int i = 0; i < 4; ++i) cXs[i] = gXs[i];
        }
        __syncthreads();
    }
}

__device__ __forceinline__ void s5_carry(const Params& p, int l, int it) {
    float* S5C = (float*)(p.ws + WS_S5C);
    const int idx = it * 512 + otid();
    const int b = idx / 1536, gp = idx % 1536, g = gp >> 6;
    const float re = p.in[10][l * 1536 + gp], im = p.in[11][l * 1536 + gp], dt = __expf(p.in[12][l * 24 + g]);
    const float ea = __expf(64.0f * re * dt), th = 64.0f * im * dt;
    const float lr = ea * cosf(th), li = ea * sinf(th);
    float Xr = 0.f, Xi = 0.f;
    for (int n = 0; n < 64; ++n) {
        const size_t ci = (((size_t)b * 64 + n) * 1536 + gp) * 2;
        const float a = S5C[ci], c = S5C[ci + 1];
        S5C[ci] = Xr; S5C[ci + 1] = Xi;
        const float nr = lr * Xr - li * Xi + a, ni = lr * Xi + li * Xr + c;
        Xr = nr; Xi = ni;
    }
}
__device__ __forceinline__ void lru_carry(const Params& p, int it) {
    float* LA = (float*)(p.ws + WS_LA); float* LH = (float*)(p.ws + WS_LH);
    const int idx = it * 512 + otid();
    const int b = idx >> 9, ch = idx & 511;
    float H = 0.f;
    for (int n = 0; n < 64; ++n) {
        const size_t ci = ((size_t)b * 64 + n) * 512 + ch;
        const float a = LA[ci], hl = LH[ci];
        LH[ci] = H;
        H = a * H + hl;
    }
}

__device__ __forceinline__ void gdn_post(const Params& p, int l, int b, int n, float* sm) {
    bf16_t* proj = (bf16_t*)(p.ws + WS_PROJ);
    const int tid = otid(), wid = __builtin_amdgcn_readfirstlane(tid >> 6), lane = tid & 63;
    const size_t tok0 = (size_t)b * SEQ + n * 64;
    float* Tt = sm;
#pragma unroll 1
    for (int h = 0; h < 4; ++h) {
#pragma unroll
        for (int q = 0; q < 2; ++q) {
            const int idx = tid + 512 * q, grow = idx >> 4, pc = idx & 15, e = 2 * grow + (pc >> 3), c0 = (pc & 7) * 8;
            const u32x4 v = *(const u32x4*)(proj + (tok0 + grow) * PC + OV + h * 128 + pc * 8);
            const f32x4 a = up4((u32x2){v.x, v.y}), bq = up4((u32x2){v.z, v.w});
#pragma unroll
            for (int i = 0; i < 4; ++i) { Tt[e * 65 + c0 + i] = a[i]; Tt[e * 65 + c0 + 4 + i] = bq[i]; }
        }
        __syncthreads();
        const float nw0 = p.in[22][l * 128 + lane], nw1 = p.in[22][l * 128 + lane + 64];
        for (int c = wid * 8; c < wid * 8 + 8; ++c) {
            const float o0 = Tt[lane * 65 + c], o1 = Tt[(lane + 64) * 65 + c];
            const float ss = wave_sum(o0 * o0 + o1 * o1);
            const float rstd = rsqrtf(ss * (1.0f / 128.0f) + 1e-6f);
            bf16_t* op = proj + (tok0 + c) * PC + OV + h * 128;
            const bf16_t* zp = proj + (tok0 + c) * PC + OZG + h * 128;
            op[lane] = f2bf(o0 * rstd * nw0 * siluf_(bf2f(zp[lane])));
            op[lane + 64] = f2bf(o1 * rstd * nw1 * siluf_(bf2f(zp[lane + 64])));
        }
        __syncthreads();
    }
}
__device__ __forceinline__ void ssd_post(const Params& p, int l, int b, int n, float* sm) {
    bf16_t* proj = (bf16_t*)(p.ws + WS_PROJ);
    const int tid = otid(), wid = __builtin_amdgcn_readfirstlane(tid >> 6), lane = tid & 63;
    const size_t tok0 = (size_t)b * SEQ + n * 64;
    float* Y = sm;
#pragma unroll
    for (int q = 0; q < 8; ++q) {
        const int idx = tid + 512 * q, j = idx >> 9, prow = (idx >> 3) & 63, pc = idx & 7;
        const u32x4 v = *(const u32x4*)(proj + (tok0 + prow) * PC + OXS + j * 64 + pc * 8);
        const f32x4 a = up4((u32x2){v.x, v.y}), bq = up4((u32x2){v.z, v.w});
#pragma unroll
        for (int i = 0; i < 4; ++i) { Y[(pc * 8 + i) * 516 + j * 64 + prow] = a[i]; Y[(pc * 8 + 4 + i) * 516 + j * 64 + prow] = bq[i]; }
    }
    __syncthreads();
    for (int r = wid * 8; r < wid * 8 + 8; ++r) {
        bf16_t* yp = proj + (tok0 + r) * PC + OXS;
        const bf16_t* zp = proj + (tok0 + r) * PC + OZS;
        float v[8]; float ss = 0.f;
#pragma unroll
        for (int k = 0; k < 8; ++k) { const int c = lane + 64 * k; v[k] = Y[r * 516 + c] * siluf_(bf2f(zp[c])); ss += v[k] * v[k]; }
        ss = wave_sum(ss);
        const float rstd = rsqrtf(ss * (1.0f / 512.0f) + 1e-6f);
#pragma unroll
        for (int k = 0; k < 8; ++k) { const int c = lane + 64 * k; yp[c] = f2bf(v[k] * rstd * p.in[26][l * 512 + c]); }
    }
    __syncthreads();
}

#define OPQ(v) asm volatile("" : "+s"(v))
#define FRESHP const Params& p = *kparams(); float* mod = (float*)(p.ws + WS_MOD); bf16_t* proj = (bf16_t*)(p.ws + WS_PROJ); bf16_t* hbuf = (bf16_t*)(p.ws + WS_H); bf16_t* mbuf = (bf16_t*)(p.ws + WS_M); const float* modl = mod + (size_t)l * 8 * 6144; const float* xin = (l == 0) ? p.in[0] : p.out; (void)proj; (void)hbuf; (void)mbuf; (void)modl; (void)xin;
template <int LL> __device__ __forceinline__ void run_layer(float* sm, LAS unsigned char* lds) {
    int l = LL;
        { FRESHP convert_layer(p, l, sm); }
        if (l == 0) cg::this_grid().sync();
        OPQ(l);
        { FRESHP norm_phase(xin, p.in[2] + l * 1024, modl, 0, 1024, hbuf); }
        cg::this_grid().sync(); OPQ(l);
        { FRESHP ProgProj pg; pg.ord.init(128, 19, ogrid(), obid()); pg.A = (const char*)hbuf; pg.B = (const char*)(p.ws + WS_BTIN); pg.proj = proj; pg.halo = (bf16_t*)(p.ws + WS_HALO); gemm_run(lds, pg); }
        cg::this_grid().sync(); OPQ(l);
        { FRESHP for (int it = obid(), G = ogrid(); it < 2048 + 1536; it += G) {
            if (it < 2048) { const int tl = it >> 2, h = it & 3; gdn_prep(p, l, tl >> 6, tl & 63, h, sm); }
            else { const int r = it - 2048, part = r / 512, tl = r % 512; const int b = tl >> 6, n = tl & 63;
                if (part == 0) ssd_prep(p, l, b, n, sm); else if (part == 1) lru_chunk<0>(p, l, b, n, sm); else s5_chunk<0>(p, l, b, n, sm); }
        } }
        cg::this_grid().sync(); OPQ(l);
        { FRESHP for (int it = obid(), G = ogrid(); it < 64 + 64 + 24 + 8; it += G) {
            if (it < 64) gdn_seq(p, it >> 3, (it >> 1) & 3, it & 1, sm);
            else if (it < 128) { const int r = it - 64; ssd_seq(p, l, r >> 3, r & 7, sm); }
            else if (it < 152) s5_carry(p, l, it - 128);
            else lru_carry(p, it - 152);
            __syncthreads();
        } }
        cg::this_grid().sync(); OPQ(l);
        { FRESHP for (int it = obid(), G = ogrid(); it < 2048; it += G) {
            const int part = it / 512, tl = it % 512; const int b = tl >> 6, n = tl & 63;
            if (part == 0) s5_chunk<1>(p, l, b, n, sm); else if (part == 1) lru_chunk<1>(p, l, b, n, sm); else if (part == 2) gdn_post(p, l, b, n, sm); else ssd_post(p, l, b, n, sm);
        } }
        cg::this_grid().sync(); OPQ(l);
        { FRESHP ProgMerge pg; pg.ord.init(128, 4, ogrid(), obid()); pg.H = (const char*)hbuf; pg.Bg = (const char*)(p.ws + WS_BTIN) + (size_t)PC * 1024 * 2; pg.Bb = (const char*)(p.ws + WS_BTBR); pg.P = (const char*)proj; pg.proj = proj; pg.mb = mbuf; gemm_run(lds, pg); }
        cg::this_grid().sync(); OPQ(l);
        { FRESHP ProgRes pg; pg.ord.init(128, 4, ogrid(), obid()); pg.A = (const char*)mbuf; pg.B = (const char*)(p.ws + WS_BTOUT); pg.lda = 1024; pg.nt = 16; pg.xin = xin; pg.xout = p.out; pg.gt = modl + 2048; gemm_run(lds, pg); }
        cg::this_grid().sync(); OPQ(l);
        { FRESHP norm_phase(p.out, p.in[3] + l * 1024, modl, 3072, 4096, hbuf); }
        cg::this_grid().sync(); OPQ(l);
        { FRESHP ProgSwi pg; pg.ord.init(128, 22, ogrid(), obid()); pg.A = (const char*)hbuf; pg.B = (const char*)(p.ws + WS_BT13); pg.act = proj; gemm_run(lds, pg); }
        cg::this_grid().sync(); OPQ(l);
        { FRESHP ProgRes pg; pg.ord.init(128, 4, ogrid(), obid()); pg.A = (const char*)proj; pg.B = (const char*)(p.ws + WS_BT2); pg.lda = FH; pg.nt = 44; pg.xin = p.out; pg.xout = p.out; pg.gt = modl + 5120; gemm_run(lds, pg); }
        cg::this_grid().sync(); OPQ(l);
    }

__global__ void __launch_bounds__(512) trunk_fwd(Params p_unused) {
    extern __shared__ __attribute__((aligned(16))) unsigned char smem[];
    float* sm = (float*)smem;
    LAS unsigned char* lds = (LAS unsigned char*)smem;

    { const Params& p = *kparams(); mod_phase(p, sm); }
    run_layer<0>(sm, lds);
    run_layer<1>(sm, lds);
    { const Params& p = *kparams(); final_norm_phase(p.out, p.in[4]); }
}

extern "C" void kernel_launch(void* const* d_in, const int* in_sizes, int n_in, void* d_out, int out_size, void* d_ws, size_t ws_size, hipStream_t stream) {
    static int grid = 0;
    if (grid == 0) {
        if (n_in != 36 || ws_size < WS_END) { fprintf(stderr, "kernel_launch: need 36 inputs and >= %zu bytes of workspace; got %d, %zu\n", (size_t)WS_END, n_in, ws_size); grid = -1; return; }
        int dev = 0, cus = 0, per_cu = 0;
        (void)hipGetDevice(&dev);
        (void)hipDeviceGetAttribute(&cus, hipDeviceAttributeMultiprocessorCount, dev);
        if (hipFuncSetAttribute((const void*)trunk_fwd, hipFuncAttributeMaxDynamicSharedMemorySize, LDS_BYTES) != hipSuccess) { fprintf(stderr, "kernel_launch: hipFuncSetAttribute failed\n"); grid = -1; return; }
        if (hipOccupancyMaxActiveBlocksPerMultiprocessor(&per_cu, (const void*)trunk_fwd, 512, LDS_BYTES) != hipSuccess || per_cu < 1) { fprintf(stderr, "kernel_launch: occupancy query says %d\n", per_cu); per_cu = 1; }
        (void)hipGetLastError();
        grid = cus * 1;
    }
    if (grid < 0) return;
    Params p{};
    for (int i = 0; i < 36; ++i) p.in[i] = (const float*)d_in[i];
    p.out = (float*)d_out; p.ws = (unsigned char*)d_ws;
    void* args[] = {&p};
    hipError_t e = hipLaunchCooperativeKernel((const void*)trunk_fwd, dim3(grid), dim3(512), args, LDS_BYTES, stream);
    if (e != hipSuccess) fprintf(stderr, "cooperative launch failed: %s (grid %d)\n", hipGetErrorString(e), grid);
}
```

```cpp
#include <hip/hip_runtime.h>
#include <hip/hip_cooperative_groups.h>
#include <cstdio>
namespace cg = cooperative_groups;

#define LAS __attribute__((address_space(3)))
typedef unsigned short bf16_t;
typedef short bf16x8 __attribute__((ext_vector_type(8)));
typedef float f32x4 __attribute__((ext_vector_type(4)));
typedef float f32x2 __attribute__((ext_vector_type(2)));
typedef unsigned u32x2 __attribute__((ext_vector_type(2)));
typedef unsigned u32x4 __attribute__((ext_vector_type(4)));

constexpr int T_ = 32768, D_ = 1024, NB = 8, SEQ = 4096, NCH = 64, PC = 4752, INC = 8848, CONVC = 2816, FH = 2816;
constexpr int OQ = 0, OKK = 512, OV = 1024, OXS = 1536, OBS = 2048, OCS = 2176, OXL = 2304, OU5 = 2816, OBG = 3200, OAG = 3204, OZG = 3208, OZS = 3720, ODT = 4232, OGL = 4240;
constexpr size_t WS_BTIN = 0, WS_BTBR = 18120704, WS_BTOUT = 22052864, WS_BT13 = 24150016, WS_BT2 = 35684352, WS_H = 41451520, WS_M = 108560384,
                 WS_PROJ = 175669248, WS_HALO = 487096320, WS_MOD = 495747072, WS_DT = 496140288, WS_CS = 497188864, WS_GC = 498237440, WS_S5C = 498761728,
                 WS_LA = 505053184, WS_LH = 506101760, WS_PAR = 507150336, WS_END = 507150336 + 1024 * 512;
constexpr int LDS_BYTES = 160 * 1024;

struct Params {
    const float* in[36];
    float* out;
    unsigned char* ws;
};

__device__ __forceinline__ int otid() { int t = threadIdx.x; asm volatile("" : "+v"(t)); return t; }
__device__ __forceinline__ int obid() { int t = blockIdx.x; asm volatile("" : "+s"(t)); return t; }
struct Params;
__device__ __forceinline__ const Params* kparams() { auto k = __builtin_amdgcn_kernarg_segment_ptr(); asm volatile("" : "+s"(k)); return (const Params*)k; }
__device__ __forceinline__ int ogrid() { int t = gridDim.x; asm volatile("" : "+s"(t)); return t; }
__device__ __forceinline__ float bf2f(bf16_t v) { return __uint_as_float(((unsigned)v) << 16); }
__device__ __forceinline__ bf16_t f2bf(float f) { unsigned r; asm("v_cvt_pk_bf16_f32 %0, %1, %1" : "=v"(r) : "v"(f)); return (bf16_t)(r & 0xffffu); }
__device__ __forceinline__ unsigned pk2(float lo, float hi) { unsigned r; asm("v_cvt_pk_bf16_f32 %0, %1, %2" : "=v"(r) : "v"(lo), "v"(hi)); return r; }
__device__ __forceinline__ float sigmoidf_(float x) { return __builtin_amdgcn_rcpf(1.0f + __expf(-x)); }
__device__ __forceinline__ float siluf_(float x) { return x * __builtin_amdgcn_rcpf(1.0f + __expf(-x)); }
__device__ __forceinline__ float softplusf_(float x) { return fmaxf(x, 0.f) + log1pf(__expf(-fabsf(x))); }
__device__ __forceinline__ float geluf_(float x) { const float u = 0.7978845608028654f * (x + 0.044715f * x * x * x); return x - x * __builtin_amdgcn_rcpf(1.0f + __expf(2.0f * u)); }
__device__ __forceinline__ int pperm(int d) { return (d & ~31) | (((d >> 2) & 3) << 3) | (((d >> 4) & 1) << 2) | (d & 3); }
__device__ __forceinline__ int iperm(int q) { return (q & ~31) | (((q >> 2) & 1) << 4) | (((q >> 3) & 3) << 2) | (q & 3); }
__device__ __forceinline__ bf16x8 pack8(const f32x4 a, const f32x4 b) { u32x4 r; r.x = pk2(a[0], a[1]); r.y = pk2(a[2], a[3]); r.z = pk2(b[0], b[1]); r.w = pk2(b[2], b[3]); return __builtin_bit_cast(bf16x8, r); }
__device__ __forceinline__ f32x4 up4(u32x2 v) { f32x4 r; r[0] = __uint_as_float(v.x << 16); r[1] = __uint_as_float(v.x & 0xffff0000u); r[2] = __uint_as_float(v.y << 16); r[3] = __uint_as_float(v.y & 0xffff0000u); return r; }
__device__ __forceinline__ float wave_incl_scan(float v, int lane) {
#pragma unroll
    for (int o = 1; o < 64; o <<= 1) { const float t = __shfl_up(v, o); if (lane >= o) v += t; }
    return v;
}
__device__ __forceinline__ float wave_sum(float v) {
#pragma unroll
    for (int o = 32; o > 0; o >>= 1) v += __shfl_xor(v, o);
    return v;
}

constexpr int HTB = 128 * 64 * 2;
__device__ __forceinline__ int lds_byte(int r, int c) { const int st = (r >> 4) * 2 + (c >> 5), rr = r & 15, cc = c & 31, ob = rr * 64 + cc * 2; return st * 1024 + (ob ^ (((ob >> 9) & 1) << 5)); }
__device__ __forceinline__ void stage_rc(int b, int& R, int& C) { const int st = b / 1024, sb = b % 1024, swz = sb ^ (((sb >> 9) & 1) << 5); R = (st >> 1) * 16 + swz / 64; C = (st & 1) * 32 + (swz % 64) / 2; }

__device__ __forceinline__ int perm32(int rho) { const int n = rho >> 4, i = rho & 15; return 8 * (i >> 2) + 4 * n + (i & 3); }
struct GU { const char* A; const char* B; int lda; int nt; int pm, pn, sub; };

struct TileOrder {
    int nM, nN, nwg, G, c;
    __device__ void init(int nM_, int nN_, int G_, int c_) { nM = nM_; nN = nN_; nwg = nM * nN; G = G_; c = c_; }
    __device__ bool tile(int i, int& pm, int& pn) const {
        const long L = (long)i * G + c; if (L >= nwg) return false;
        int wgid = (int)L; { const int q = nwg / 8, r = nwg % 8, xcd = wgid % 8, off = wgid / 8; wgid = (xcd < r ? xcd * (q + 1) : r * (q + 1) + (xcd - r) * q) + off; }
        const int nig = 8 * nN, gid = wgid / nig, fm = gid * 8, gsz = (nM - fm) < 8 ? (nM - fm) : 8;
        pm = fm + ((wgid % nig) % gsz); pn = (wgid % nig) / gsz; return true;
    }
};

template <class P>
__device__ __forceinline__ void gemm_run(LAS unsigned char* lds, const P& prog) {
    const int tid = otid(), wid = __builtin_amdgcn_readfirstlane(tid >> 6), lane = tid & 63, wr = wid >> 2, wc = wid & 3, fr = lane & 15, fq = lane >> 4;
    const unsigned ldsw = (unsigned)wid * 1024u;
    const int aoff = lds_byte(wr * 64 + fr, fq * 8), boff = lds_byte(wc * 32 + fr, fq * 8);
#define G_SA(b, h) (((b) * 2 + (h)) * HTB)
#define G_SB(b, h) ((4 + (b) * 2 + (h)) * HTB)
#define G_STAGE(bufoff, gbase, voff) do { _Pragma("unroll") for (int _i = 0; _i < 2; ++_i) \
        __builtin_amdgcn_global_load_lds((const unsigned*)((const char*)(gbase) + (voff)[_i]), (LAS unsigned*)(lds + (bufoff) + ldsw + _i * 8192), 16, 0, 0); } while (0)
#define G_LDA(dst, b, h) do { _Pragma("unroll") for (int m = 0; m < 4; ++m) _Pragma("unroll") for (int k = 0; k < 2; ++k) dst[m][k] = *(const LAS bf16x8*)(lds + G_SA(b, h) + aoff + m * 2048 + k * 1024); } while (0)
#define G_LDB(dst, b, h) do { _Pragma("unroll") for (int n = 0; n < 2; ++n) _Pragma("unroll") for (int k = 0; k < 2; ++k) dst[n][k] = *(const LAS bf16x8*)(lds + G_SB(b, h) + boff + n * 2048 + k * 1024); } while (0)
#define G_MMA(ai, bj, At, Bt) do { __builtin_amdgcn_s_setprio(1); _Pragma("unroll") for (int m = 0; m < 4; ++m) _Pragma("unroll") for (int n = 0; n < 2; ++n) _Pragma("unroll") for (int k = 0; k < 2; ++k) \
        acc[ai][bj][m][n] = __builtin_amdgcn_mfma_f32_16x16x32_bf16(Bt[n][k], At[m][k], acc[ai][bj][m][n], 0, 0, 0); __builtin_amdgcn_s_setprio(0); } while (0)
#define G_WAIT_V(n) asm volatile("s_waitcnt vmcnt(" #n ")" ::: "memory")
#define G_WAIT_L(n) asm volatile("s_waitcnt lgkmcnt(" #n ")" ::: "memory")
#define G_BAR __builtin_amdgcn_s_barrier()
#define G_SCHED __builtin_amdgcn_sched_barrier(0)
    GU cur, nxt; int ui = 0;
    if (!prog.get(0, cur)) return;
    f32x4 acc[2][2][4][2];
#pragma unroll
    for (int a = 0; a < 2; ++a)
#pragma unroll
        for (int b = 0; b < 2; ++b)
#pragma unroll
            for (int m = 0; m < 4; ++m)
#pragma unroll
                for (int n = 0; n < 2; ++n) acc[a][b][m][n] = (f32x4){0.f, 0.f, 0.f, 0.f};
    bf16x8 At[4][2], B0[2][2], B1[2][2];
    unsigned cvA[2], cvB[2], nvA[2], nvB[2];
#pragma unroll
    for (int i = 0; i < 2; ++i) { int R, C; stage_rc(tid * 16 + i * 8192, R, C); const int Rb = 64 * (R >> 5) + perm32(R & 31); cvA[i] = (unsigned)(R * cur.lda + C) * 2u; cvB[i] = (unsigned)(Rb * cur.nt * 64 + C) * 2u; }
    unsigned chA = 256u * cur.lda, chB = 64u * cur.nt * 64;
    const size_t kstep = 128;
    const char* cA = cur.A; const char* cB = cur.B;
    G_STAGE(G_SB(0, 0), cB, cvB); G_STAGE(G_SA(0, 0), cA, cvA); G_STAGE(G_SB(0, 1), cB + chB, cvB); G_STAGE(G_SA(0, 1), cA + chA, cvA);
    if (wr == 1) G_BAR;
    G_WAIT_V(4); G_BAR;
    G_STAGE(G_SB(1, 0), cB + kstep, cvB); G_STAGE(G_SA(1, 0), cA + kstep, cvA); G_STAGE(G_SB(1, 1), cB + chB + kstep, cvB);
    G_WAIT_V(6); G_BAR;
    for (;;) {
        const bool has_next = prog.get(ui + 1, nxt);
        if (!has_next) nxt = cur;
        const char* nA = nxt.A; const char* nB = nxt.B;
        { int t2 = tid; asm volatile("" : "+v"(t2));
#pragma unroll
          for (int i = 0; i < 2; ++i) { int R, C; stage_rc(t2 * 16 + i * 8192, R, C); const int Rb = 64 * (R >> 5) + perm32(R & 31); nvA[i] = (unsigned)(R * nxt.lda + C) * 2u; nvB[i] = (unsigned)(Rb * nxt.nt * 64 + C) * 2u; } }
        const unsigned nhA = 256u * nxt.lda, nhB = 64u * nxt.nt * 64;
        const int nt = cur.nt;
        for (int t = 0; t < nt; t += 2) {
            const bool last = (t == nt - 2);
            const char* a1 = cA + (size_t)(t + 1) * kstep;
            const char* a2 = last ? nA : cA + (size_t)(t + 2) * kstep; const char* b2 = last ? nB : cB + (size_t)(t + 2) * kstep;
            const char* a3 = a2 + kstep; const char* b3 = b2 + kstep;
            unsigned vA2[2], vB2[2];
#pragma unroll
            for (int i = 0; i < 2; ++i) { vA2[i] = last ? nvA[i] : cvA[i]; vB2[i] = last ? nvB[i] : cvB[i]; }
            const unsigned hA2 = last ? nhA : chA, hB2 = last ? nhB : chB;
            G_LDB(B0, 0, 0); G_SCHED; G_LDA(At, 0, 0); G_STAGE(G_SA(1, 1), a1 + chA, cvA);
            G_WAIT_L(8); G_BAR; G_WAIT_L(0); G_MMA(0, 0, At, B0); G_BAR; G_SCHED;
            G_LDB(B1, 0, 1); G_STAGE(G_SB(0, 0), b2, vB2);
            G_BAR; G_WAIT_L(0); G_MMA(0, 1, At, B1); G_BAR;
            G_LDA(At, 0, 1); G_STAGE(G_SA(0, 0), a2, vA2);
            G_BAR; G_WAIT_L(0); G_MMA(1, 0, At, B0); G_BAR; G_SCHED;
            G_STAGE(G_SB(0, 1), b2 + hB2, vB2);
            G_WAIT_V(6); G_BAR; G_MMA(1, 1, At, B1); G_BAR;
            G_LDB(B0, 1, 0); G_SCHED; G_LDA(At, 1, 0); G_STAGE(G_SA(0, 1), a2 + hA2, vA2);
            G_WAIT_L(8); G_BAR; G_WAIT_L(0); G_MMA(0, 0, At, B0); G_BAR; G_SCHED;
            G_LDB(B1, 1, 1); G_STAGE(G_SB(1, 0), b3, vB2);
            G_BAR; G_WAIT_L(0); G_MMA(0, 1, At, B1); G_BAR;
            G_LDA(At, 1, 1); G_STAGE(G_SA(1, 0), a3, vA2);
            G_BAR; G_WAIT_L(0); G_MMA(1, 0, At, B0); G_BAR; G_SCHED;
            G_STAGE(G_SB(1, 1), b3 + hB2, vB2);
            G_WAIT_V(6); G_BAR; G_MMA(1, 1, At, B1); G_BAR;
        }
        prog.epi(acc, cur, wr, wc, fr, fq);
        if (!has_next) break;
#pragma unroll
        for (int a = 0; a < 2; ++a)
#pragma unroll
            for (int b = 0; b < 2; ++b)
#pragma unroll
                for (int m = 0; m < 4; ++m)
#pragma unroll
                    for (int n = 0; n < 2; ++n) acc[a][b][m][n] = (f32x4){0.f, 0.f, 0.f, 0.f};
        cur = nxt; cA = nA; cB = nB; chA = nhA; chB = nhB;
#pragma unroll
        for (int i = 0; i < 2; ++i) { cvA[i] = nvA[i]; cvB[i] = nvB[i]; }
        ++ui;
    }
    G_WAIT_V(0);
    if (wr == 0) G_BAR;
    G_BAR;
#undef G_SA
#undef G_SB
#undef G_STAGE
#undef G_LDA
#undef G_LDB
#undef G_MMA
#undef G_WAIT_V
#undef G_WAIT_L
#undef G_BAR
#undef G_SCHED
}

struct ProgProj {
    TileOrder ord; const char* A; const char* B; bf16_t* proj; bf16_t* halo;
    __device__ bool get(int i, GU& u) const { if (!ord.tile(i, u.pm, u.pn)) return false; u.A = A + (size_t)u.pm * 256 * 1024 * 2; u.B = B + (size_t)u.pn * 256 * 1024 * 2; u.lda = 1024; u.nt = 16; u.sub = 0; return true; }
    __device__ __forceinline__ void epi(const f32x4 (&acc)[2][2][4][2], const GU& u, int wr, int wc, int fr, int fq) const {
#pragma unroll
        for (int ai = 0; ai < 2; ++ai)
#pragma unroll
            for (int m = 0; m < 4; ++m) {
                const int row = u.pm * 256 + ai * 128 + wr * 64 + m * 16 + fr;
                const int r6 = row & 63;
#pragma unroll
                for (int bj = 0; bj < 2; ++bj) {
                    const int col = u.pn * 256 + wc * 64 + bj * 32 + 8 * fq;
                    const f32x4 v0 = acc[ai][bj][m][0], v1 = acc[ai][bj][m][1];
                    u32x4 pk; pk.x = pk2(v0[0], v0[1]); pk.y = pk2(v0[2], v0[3]); pk.z = pk2(v1[0], v1[1]); pk.w = pk2(v1[2], v1[3]);
                    if (col < PC) *(u32x4*)(proj + (size_t)row * PC + col) = pk;
                    if (col < CONVC && r6 >= 61) *(u32x4*)(halo + ((size_t)(row >> 6) * 3 + (r6 - 61)) * CONVC + col) = pk;
                }
            }
    }
};

struct ProgMerge {
    TileOrder ord; const char* H; const char* Bg; const char* Bb; const char* P; bf16_t* proj; bf16_t* mb;
    __device__ bool get(int i, GU& u) const {
        const int tl = i >> 3, sub = i & 7;
        if (!ord.tile(tl, u.pm, u.pn)) return false;
        u.sub = sub; const int br = sub >> 1;
        if (!(sub & 1)) { u.A = H + (size_t)u.pm * 256 * 1024 * 2; u.lda = 1024; u.nt = 16; u.B = Bg + ((size_t)br * 1024 + (size_t)u.pn * 256) * 1024 * 2; }
        else {
            const int kb = (br == 0) ? 384 : 512; const int ycol = (br == 0) ? OU5 : (br == 1) ? OV : (br == 2) ? OXS : OXL; const int koff = (br == 0) ? 0 : 384 + (br - 1) * 512;
            u.A = P + ((size_t)u.pm * 256 * PC + ycol) * 2; u.lda = PC; u.nt = kb / 64; u.B = Bb + (size_t)koff * 1024 * 2 + (size_t)u.pn * 256 * kb * 2;
        }
        return true;
    }
    __device__ __forceinline__ void epi(const f32x4 (&acc)[2][2][4][2], const GU& u, int wr, int wc, int fr, int fq) const {
        const int sub = u.sub;
#pragma unroll
        for (int ai = 0; ai < 2; ++ai)
#pragma unroll
            for (int m = 0; m < 4; ++m) {
                const int row = u.pm * 256 + ai * 128 + wr * 64 + m * 16 + fr;
#pragma unroll
                for (int bj = 0; bj < 2; ++bj) {
                    const int col = u.pn * 256 + wc * 64 + bj * 32 + 8 * fq;
                    const f32x4 v0 = acc[ai][bj][m][0], v1 = acc[ai][bj][m][1];
                    bf16_t* st = proj + (size_t)row * PC + col;
                    bf16_t* mp = mb + (size_t)row * 1024 + col;
                    if (!(sub & 1)) {
                        u32x4 pk; pk.x = pk2(sigmoidf_(v0[0]), sigmoidf_(v0[1])); pk.y = pk2(sigmoidf_(v0[2]), sigmoidf_(v0[3])); pk.z = pk2(sigmoidf_(v1[0]), sigmoidf_(v1[1])); pk.w = pk2(sigmoidf_(v1[2]), sigmoidf_(v1[3]));
                        *(u32x4*)st = pk;
                    } else {
                        const u32x4 g = *(const u32x4*)st;
                        f32x4 r0 = up4((u32x2){g.x, g.y}) * v0, r1 = up4((u32x2){g.z, g.w}) * v1;
                        if (sub > 1) { const u32x4 o = *(const u32x4*)mp; r0 = r0 + up4((u32x2){o.x, o.y}); r1 = r1 + up4((u32x2){o.z, o.w}); }
                        u32x4 pk; pk.x = pk2(r0[0], r0[1]); pk.y = pk2(r0[2], r0[3]); pk.z = pk2(r1[0], r1[1]); pk.w = pk2(r1[2], r1[3]);
                        *(u32x4*)mp = pk;
                    }
                }
            }
    }
};

struct ProgRes {
    TileOrder ord; const char* A; const char* B; int lda, nt; const float* xin; float* xout; const float* gt;
    __device__ bool get(int i, GU& u) const { if (!ord.tile(i, u.pm, u.pn)) return false; u.A = A + (size_t)u.pm * 256 * lda * 2; u.B = B + (size_t)u.pn * 256 * (nt * 64) * 2; u.lda = lda; u.nt = nt; u.sub = 0; return true; }
    __device__ __forceinline__ void epi(const f32x4 (&acc)[2][2][4][2], const GU& u, int wr, int wc, int fr, int fq) const {
        const int bidx = (u.pm * 256) >> 12;
        f32x4 gv[2][2];
#pragma unroll
        for (int bj = 0; bj < 2; ++bj)
#pragma unroll
            for (int n = 0; n < 2; ++n) gv[bj][n] = *(const f32x4*)(gt + (size_t)bidx * 6144 + u.pn * 256 + wc * 64 + bj * 32 + 8 * fq + 4 * n);
#pragma unroll
        for (int bj = 0; bj < 2; ++bj)
#pragma unroll
            for (int n = 0; n < 2; ++n) {
                const int col = u.pn * 256 + wc * 64 + bj * 32 + 8 * fq + 4 * n;
                const f32x4 g = gv[bj][n];
#pragma unroll
                for (int ai = 0; ai < 2; ++ai)
#pragma unroll
                    for (int mp = 0; mp < 2; ++mp) {
                        const int row0 = u.pm * 256 + ai * 128 + wr * 64 + (2 * mp) * 16 + fr, row1 = row0 + 16;
                        const f32x4 xa = *(const f32x4*)(xin + (size_t)row0 * 1024 + col), xb2 = *(const f32x4*)(xin + (size_t)row1 * 1024 + col);
                        *(f32x4*)(xout + (size_t)row0 * 1024 + col) = xa + g * acc[ai][bj][2 * mp][n];
                        *(f32x4*)(xout + (size_t)row1 * 1024 + col) = xb2 + g * acc[ai][bj][2 * mp + 1][n];
                    }
            }
    }
};

struct ProgSwi {
    TileOrder ord; const char* A; const char* B; bf16_t* act;
    __device__ bool get(int i, GU& u) const { if (!ord.tile(i, u.pm, u.pn)) return false; u.A = A + (size_t)u.pm * 256 * 1024 * 2; u.B = B + (size_t)u.pn * 256 * 1024 * 2; u.lda = 1024; u.nt = 16; u.sub = 0; return true; }
    __device__ __forceinline__ void epi(const f32x4 (&acc)[2][2][4][2], const GU& u, int wr, int wc, int fr, int fq) const {
#pragma unroll
        for (int ai = 0; ai < 2; ++ai)
#pragma unroll
            for (int m = 0; m < 4; ++m) {
                const int row = u.pm * 256 + ai * 128 + wr * 64 + m * 16 + fr;
                const int col = u.pn * 128 + wc * 32 + 8 * fq;
                const f32x4 a0 = acc[ai][0][m][0], b0 = acc[ai][1][m][0], a1 = acc[ai][0][m][1], b1 = acc[ai][1][m][1];
                u32x4 pk; pk.x = pk2(siluf_(a0[0]) * b0[0], siluf_(a0[1]) * b0[1]); pk.y = pk2(siluf_(a0[2]) * b0[2], siluf_(a0[3]) * b0[3]);
                pk.z = pk2(siluf_(a1[0]) * b1[0], siluf_(a1[1]) * b1[1]); pk.w = pk2(siluf_(a1[2]) * b1[2], siluf_(a1[3]) * b1[3]);
                *(u32x4*)(act + (size_t)row * FH + col) = pk;
            }
    }
};

struct CDesc { const float* src; bf16_t* dst; int ld_src, k0, n0, nmax, ld_dst, mode; };
__device__ __forceinline__ void convert_decode(const Params& p, int l, int it, CDesc& d) {
    int j, r = it;
    if (r < 2224) j = 0; else if (r < 2320) { j = 1; r -= 2224; } else if (r < 2448) { j = 2; r -= 2320; } else if (r < 2576) { j = 3; r -= 2448; } else if (r < 2704) { j = 4; r -= 2576; }
    else if (r < 2960) { j = 5; r -= 2704; } else if (r < 4368) { j = 6; r -= 2960; } else if (r < 5072) { j = 7; r -= 4368; } else if (r < 5108) { j = 8; r -= 5072; } else { j = 9; r -= 5108; }
    int KT; d.mode = 0;
    if (j == 0) { d.src = p.in[7] + (size_t)l * 1024 * INC; d.ld_src = INC; KT = 16; d.nmax = INC; d.dst = (bf16_t*)(p.ws + WS_BTIN); d.ld_dst = 1024; }
    else if (j <= 4) { const int br = j - 1; const int kb = br == 0 ? 384 : 512, koff = br == 0 ? 0 : 384 + (br - 1) * 512;
        d.src = p.in[32] + (size_t)l * 1920 * 1024 + (size_t)koff * 1024; d.ld_src = 1024; KT = kb / 64; d.nmax = 1024; d.dst = (bf16_t*)(p.ws + WS_BTBR) + (size_t)koff * 1024; d.ld_dst = kb; }
    else if (j == 5) { d.src = p.in[33] + (size_t)l * 1024 * 1024; d.ld_src = 1024; KT = 16; d.nmax = 1024; d.dst = (bf16_t*)(p.ws + WS_BTOUT); d.ld_dst = 1024; }
    else if (j == 6) { d.src = p.in[34] + (size_t)l * 1024 * 5632; d.ld_src = 5632; KT = 16; d.nmax = 5632; d.dst = (bf16_t*)(p.ws + WS_BT13); d.ld_dst = 1024; d.mode = 1; }
    else if (j == 7) { d.src = p.in[35] + (size_t)l * FH * 1024; d.ld_src = 1024; KT = 44; d.nmax = 1024; d.dst = (bf16_t*)(p.ws + WS_BT2); d.ld_dst = FH; }
    else if (j == 8) { d.src = p.in[18] + (size_t)l * 384 * 384; d.ld_src = 384; KT = 6; d.nmax = 384; d.dst = (bf16_t*)(p.ws + WS_PAR); d.ld_dst = 384; }
    else { const int gate = r >> 3, nb = r & 7; d.src = (gate ? p.in[30] : p.in[28]) + (size_t)(l * 8 + nb) * 4096; d.ld_src = 64; KT = 1; d.nmax = 64; d.dst = (bf16_t*)(p.ws + WS_PAR + 294912) + (size_t)(gate * 8 + nb) * 4096; d.ld_dst = 64; r = 0; }
    d.n0 = (r / KT) * 64; d.k0 = (r % KT) * 64;
}
__device__ __forceinline__ void convert_layer(const Params& p, int l, float* sm) {
    const int total = 5124;
    const int tid = otid(), G = ogrid();
    int it = obid();
    if (it >= total) return;
    CDesc d; convert_decode(p, l, it, d);
    float v[8];
    {
        const int nn = tid & 63, n = d.n0 + nn;
#pragma unroll
        for (int i = 0; i < 8; ++i) { const int kk = (tid >> 6) + 8 * i; v[i] = (n < d.nmax) ? d.src[(size_t)(d.k0 + kk) * d.ld_src + n] : 0.f; }
    }
    int buf = 0;
    for (;;) {
        float* T = sm + buf * 4160;
        {
            const int nn = tid & 63;
#pragma unroll
            for (int i = 0; i < 8; ++i) { const int kk = (tid >> 6) + 8 * i; T[kk * 65 + nn] = v[i]; }
        }
        const bool has_next = (it + G < total);
        CDesc dn = d;
        if (has_next) {
            convert_decode(p, l, it + G, dn);
            const int nn = tid & 63, n = dn.n0 + nn;
#pragma unroll
            for (int i = 0; i < 8; ++i) { const int kk = (tid >> 6) + 8 * i; v[i] = (n < dn.nmax) ? dn.src[(size_t)(dn.k0 + kk) * dn.ld_src + n] : 0.f; }
        }
        __syncthreads();
        {
            const int nn2 = tid >> 3, kk2 = (tid & 7) * 8, n = d.n0 + nn2;
            if (n < d.nmax) {
                int row = n;
                if (d.mode == 1) row = (n < FH) ? ((n >> 5) * 64 + (n & 31)) : ((((n - FH) >> 5) * 64) + 32 + ((n - FH) & 31));
                u32x4 pk;
                pk.x = pk2(T[(kk2 + 0) * 65 + nn2], T[(kk2 + 1) * 65 + nn2]); pk.y = pk2(T[(kk2 + 2) * 65 + nn2], T[(kk2 + 3) * 65 + nn2]);
                pk.z = pk2(T[(kk2 + 4) * 65 + nn2], T[(kk2 + 5) * 65 + nn2]); pk.w = pk2(T[(kk2 + 6) * 65 + nn2], T[(kk2 + 7) * 65 + nn2]);
                *(u32x4*)(d.dst + (size_t)row * d.ld_dst + d.k0 + kk2) = pk;
            }
        }
        if (!has_next) break;
        d = dn; it += G; buf ^= 1;
    }
    __syncthreads();
}

__device__ __forceinline__ void mod_phase(const Params& p, float* sm) {
    float* cond = sm;
    float* part = sm + 8192;
    float* mod = (float*)(p.ws + WS_MOD);
    const int tid = otid();
    for (int it = obid(); it < 96; it += ogrid()) {
        const int l = it / 48, cb = it % 48;
        for (int i = tid; i < 8192; i += 512) cond[i] = siluf_(p.in[1][i]);
        __syncthreads();
        const int cl = tid & 127, ks = tid >> 7, col = cb * 128 + cl;
        float a[8];
#pragma unroll
        for (int b = 0; b < 8; ++b) a[b] = 0.f;
        const float* w = p.in[5] + (size_t)l * 1024 * 6144 + col;
#pragma unroll 2
        for (int k = ks * 256; k < ks * 256 + 256; k += 4) {
            const float w0 = w[(size_t)k * 6144], w1 = w[(size_t)(k + 1) * 6144], w2 = w[(size_t)(k + 2) * 6144], w3 = w[(size_t)(k + 3) * 6144];
#pragma unroll
            for (int b = 0; b < 8; ++b) { const f32x4 c4 = *(const f32x4*)(cond + b * 1024 + k); a[b] += c4[0] * w0 + c4[1] * w1 + c4[2] * w2 + c4[3] * w3; }
        }
#pragma unroll
        for (int b = 0; b < 8; ++b) part[(ks * 8 + b) * 128 + cl] = a[b];
        __syncthreads();
        for (int i = tid; i < 1024; i += 512) {
            const int b = i >> 7, c2 = i & 127;
            const float s = part[(0 * 8 + b) * 128 + c2] + part[(1 * 8 + b) * 128 + c2] + part[(2 * 8 + b) * 128 + c2] + part[(3 * 8 + b) * 128 + c2];
            mod[((size_t)l * 8 + b) * 6144 + cb * 128 + c2] = s + p.in[6][(size_t)l * 6144 + cb * 128 + c2];
        }
        __syncthreads();
    }
}

__device__ __forceinline__ void norm_phase(const float* src, const float* g, const float* modl, int sh_off, int sc_off, bf16_t* dst) {
    const int tid = otid(), wid = __builtin_amdgcn_readfirstlane(tid >> 6), lane = tid & 63;
    const int stride = ogrid() * 8;
    int row = obid() * 8 + wid;
    if (row >= T_) return;
    f32x4 gg[4];
#pragma unroll
    for (int j = 0; j < 4; ++j) gg[j] = *(const f32x4*)(g + lane * 4 + 256 * j);
    f32x4 vn[4];
#pragma unroll
    for (int j = 0; j < 4; ++j) vn[j] = *(const f32x4*)(src + (size_t)row * 1024 + lane * 4 + 256 * j);
    for (; row < T_; row += stride) {
        const int b = row >> 12;
        f32x4 v[4]; float ss = 0.f;
#pragma unroll
        for (int j = 0; j < 4; ++j) { v[j] = vn[j]; ss += v[j][0] * v[j][0] + v[j][1] * v[j][1] + v[j][2] * v[j][2] + v[j][3] * v[j][3]; }
        if (row + stride < T_) {
#pragma unroll
            for (int j = 0; j < 4; ++j) vn[j] = *(const f32x4*)(src + (size_t)(row + stride) * 1024 + lane * 4 + 256 * j);
        }
        ss = wave_sum(ss);
        const float rstd = rsqrtf(ss * (1.0f / 1024.0f) + 1e-6f);
#pragma unroll
        for (int j = 0; j < 4; ++j) {
            const int c = lane * 4 + 256 * j;
            const f32x4 sc = *(const f32x4*)(modl + (size_t)b * 6144 + sc_off + c);
            const f32x4 sh = *(const f32x4*)(modl + (size_t)b * 6144 + sh_off + c);
            float o[4];
#pragma unroll
            for (int e = 0; e < 4; ++e) o[e] = v[j][e] * rstd * gg[j][e] * (1.0f + sc[e]) + sh[e];
            u32x2 pk; pk.x = pk2(o[0], o[1]); pk.y = pk2(o[2], o[3]);
            *(u32x2*)(dst + (size_t)row * 1024 + c) = pk;
        }
    }
}
__device__ __forceinline__ void final_norm_phase(float* x, const float* g) {
    const int tid = otid(), wid = __builtin_amdgcn_readfirstlane(tid >> 6), lane = tid & 63;
    const int stride = ogrid() * 8;
    int row = obid() * 8 + wid;
    if (row >= T_) return;
    f32x4 gg[4];
#pragma unroll
    for (int j = 0; j < 4; ++j) gg[j] = *(const f32x4*)(g + lane * 4 + 256 * j);
    f32x4 vn[4];
#pragma unroll
    for (int j = 0; j < 4; ++j) vn[j] = *(const f32x4*)(x + (size_t)row * 1024 + lane * 4 + 256 * j);
    for (; row < T_; row += stride) {
        float* xr = x + (size_t)row * 1024;
        f32x4 v[4]; float ss = 0.f;
#pragma unroll
        for (int j = 0; j < 4; ++j) { v[j] = vn[j]; ss += v[j][0] * v[j][0] + v[j][1] * v[j][1] + v[j][2] * v[j][2] + v[j][3] * v[j][3]; }
        if (row + stride < T_) {
#pragma unroll
            for (int j = 0; j < 4; ++j) vn[j] = *(const f32x4*)(x + (size_t)(row + stride) * 1024 + lane * 4 + 256 * j);
        }
        ss = wave_sum(ss);
        const float rstd = rsqrtf(ss * (1.0f / 1024.0f) + 1e-6f);
#pragma unroll
        for (int j = 0; j < 4; ++j) { const int c = lane * 4 + 256 * j; *(f32x4*)(xr + c) = v[j] * rstd * gg[j]; }
    }
}

__device__ __forceinline__ float raw_at(const bf16_t* proj, const bf16_t* halo, int b, int n, int r, int col) {
    if (r >= 0) return bf2f(proj[((size_t)(b * SEQ + n * 64 + r)) * PC + col]);
    if (n == 0) return 0.f;
    return bf2f(halo[((size_t)(b * 64 + n - 1) * 3 + (r + 3)) * CONVC + col]);
}

__device__ __forceinline__ void gdn_prep(const Params& p, int l, int b, int n, int h, float* sm) {
    bf16_t* proj = (bf16_t*)(p.ws + WS_PROJ); const bf16_t* halo = (const bf16_t*)(p.ws + WS_HALO);
    bf16_t* wbuf = (bf16_t*)(p.ws + WS_M); bf16_t* abuf = (bf16_t*)(p.ws + WS_M + 33554432);
    float* Gc = (float*)(p.ws + WS_GC);
    float* Qs = sm; float* Ks = sm + 8448; float* Vs = sm + 16896; float* Am = sm + 25344; float* At = sm + 29696; float* gb = sm + 34048; float* bt = sm + 34112;
    bf16_t* Rq = (bf16_t*)Am; bf16_t* Rk = (bf16_t*)At; bf16_t* Rv = (bf16_t*)(sm + 34176);
    const int tid = otid(), wid = __builtin_amdgcn_readfirstlane(tid >> 6), lane = tid & 63, fr = lane & 15, kg = lane >> 4;
    const size_t tok0 = (size_t)b * SEQ + n * 64;
    const float* cw = p.in[8] + (size_t)l * 4 * CONVC; const float* cbv = p.in[9] + (size_t)l * CONVC;
    {
        const int nm1 = n > 0 ? n - 1 : 0;
        u32x4 sv[7];
#pragma unroll
        for (int q = 0; q < 7; ++q) {
            int idx = tid + 512 * q; idx = idx < 3216 ? idx : 3215;
            const int row = idx / 48, rem = idx % 48, which = rem >> 4, pc = rem & 15, r = row - 3, col = which * 512 + h * 128 + pc * 8;
            const bf16_t* ptr = (r >= 0) ? proj + (tok0 + r) * PC + col : halo + ((size_t)(b * 64 + nm1) * 3 + (r + 3)) * CONVC + col;
            sv[q] = *(const u32x4*)ptr;
        }
#pragma unroll
        for (int q = 0; q < 7; ++q) {
            const int idx = tid + 512 * q;
            if (idx < 3216) {
                const int row = idx / 48, rem = idx % 48, which = rem >> 4, pc = rem & 15, r = row - 3;
                u32x4 v = sv[q];
                if (r < 0 && n == 0) v = (u32x4){0u, 0u, 0u, 0u};
                *(u32x4*)((which == 0 ? Rq : which == 1 ? Rk : Rv) + row * 128 + pc * 8) = v;
            }
        }
    }
    if (tid < 64) {
        const float braw = bf2f(proj[(tok0 + tid) * PC + OBG + h]), araw = bf2f(proj[(tok0 + tid) * PC + OAG + h]);
        bt[tid] = sigmoidf_(braw);
        gb[tid] = -__expf(p.in[20][l * 4 + h]) * softplusf_(araw + p.in[21][l * 4 + h]);
    }
    __syncthreads();
    if (wid == 7) gb[lane] = wave_incl_scan(gb[lane], lane);
    if (tid < 384) {
        const int which = tid >> 7, d = tid & 127, col = which * 512 + h * 128 + d;
        const bf16_t* R = (which == 0 ? Rq : which == 1 ? Rk : Rv) + d;
        float* O = (which == 0 ? Qs : which == 1 ? Ks : Vs) + d;
        const float w0 = cw[col], w1 = cw[CONVC + col], w2 = cw[2 * CONVC + col], w3 = cw[3 * CONVC + col], bb = cbv[col];
        float x0 = bf2f(R[0]), x1 = bf2f(R[128]), x2 = bf2f(R[256]);
#pragma unroll 8
        for (int r = 0; r < 64; ++r) {
            const float x3 = bf2f(R[(r + 3) * 128]);
            O[r * 132] = siluf_(bb + w0 * x0 + w1 * x1 + w2 * x2 + w3 * x3);
            x0 = x1; x1 = x2; x2 = x3;
        }
    }
    __syncthreads();
    {
        float q0[8], q1[8], k0[8], k1[8], sq[8], sk[8];
#pragma unroll
        for (int i = 0; i < 8; ++i) {
            const int r = wid * 8 + i;
            q0[i] = Qs[r * 132 + lane]; q1[i] = Qs[r * 132 + 64 + lane]; k0[i] = Ks[r * 132 + lane]; k1[i] = Ks[r * 132 + 64 + lane];
            sq[i] = q0[i] * q0[i] + q1[i] * q1[i]; sk[i] = k0[i] * k0[i] + k1[i] * k1[i];
        }
#pragma unroll
        for (int o = 32; o > 0; o >>= 1)
#pragma unroll
            for (int i = 0; i < 8; ++i) { sq[i] += __shfl_xor(sq[i], o); sk[i] += __shfl_xor(sk[i], o); }
#pragma unroll
        for (int i = 0; i < 8; ++i) {
            const int r = wid * 8 + i;
            const float fq_ = rsqrtf(sq[i] + 1e-6f) * 0.08838834764831845f, fk_ = rsqrtf(sk[i] + 1e-6f);
            Qs[r * 132 + lane] = q0[i] * fq_; Qs[r * 132 + 64 + lane] = q1[i] * fq_; Ks[r * 132 + lane] = k0[i] * fk_; Ks[r * 132 + 64 + lane] = k1[i] * fk_;
        }
    }
    if (tid < 64) Gc[(tok0 + tid) * 4 + h] = gb[tid];
    __syncthreads();
#pragma unroll
    for (int tt = 0; tt < 2; ++tt) {
        const int t = wid * 2 + tt, it = t >> 2, jt = t & 3;
        f32x4 kk = (f32x4){0.f, 0.f, 0.f, 0.f}, qk = (f32x4){0.f, 0.f, 0.f, 0.f};
        if (jt <= it) {
#pragma unroll
            for (int ks = 0; ks < 4; ++ks) {
                const float* ka = Ks + (16 * it + fr) * 132 + 32 * ks + 8 * kg; const float* qa = Qs + (16 * it + fr) * 132 + 32 * ks + 8 * kg; const float* kb = Ks + (16 * jt + fr) * 132 + 32 * ks + 8 * kg;
                const bf16x8 fa = pack8(*(const f32x4*)ka, *(const f32x4*)(ka + 4)), fqa = pack8(*(const f32x4*)qa, *(const f32x4*)(qa + 4)), fb = pack8(*(const f32x4*)kb, *(const f32x4*)(kb + 4));
                kk = __builtin_amdgcn_mfma_f32_16x16x32_bf16(fa, fb, kk, 0, 0, 0);
                qk = __builtin_amdgcn_mfma_f32_16x16x32_bf16(fqa, fb, qk, 0, 0, 0);
            }
        }
        const int j = 16 * jt + fr; const float gj = gb[j];
#pragma unroll
        for (int r = 0; r < 4; ++r) {
            const int i = 16 * it + 4 * kg + r;
            const float dec = (j <= i) ? __expf(gb[i] - gj) : 0.f;
            Am[i * 68 + j] = (j < i) ? bt[i] * kk[r] * dec : 0.f;
            At[i * 68 + j] = qk[r] * dec;
        }
    }
    __syncthreads();
    {
        const float glast = gb[63];
#pragma unroll
        for (int q = 0; q < 2; ++q) {
            const int idx = tid + 512 * q;
            {
                const int i = idx >> 4, pq = idx & 15; const float eg = __expf(gb[i]);
                float v[8];
#pragma unroll
                for (int e = 0; e < 8; ++e) v[e] = Qs[i * 132 + iperm(pq * 8 + e)] * eg;
                u32x4 pk; pk.x = pk2(v[0], v[1]); pk.y = pk2(v[2], v[3]); pk.z = pk2(v[4], v[5]); pk.w = pk2(v[6], v[7]);
                *(u32x4*)(proj + (tok0 + i) * PC + OQ + h * 128 + pq * 8) = pk;
            }
            {
                const int d = idx & 127, pq = idx >> 7;
                float v[8];
#pragma unroll
                for (int e = 0; e < 8; ++e) { const int c = iperm(pq * 8 + e); v[e] = Ks[c * 132 + d] * __expf(glast - gb[c]); }
                u32x4 pk; pk.x = pk2(v[0], v[1]); pk.y = pk2(v[2], v[3]); pk.z = pk2(v[4], v[5]); pk.w = pk2(v[6], v[7]);
                *(u32x4*)(proj + (tok0 + (d >> 1)) * PC + OKK + h * 128 + (d & 1) * 64 + pq * 8) = pk;
            }
        }
        {
            const int i = tid >> 3, pq = tid & 7;
            float v[8];
#pragma unroll
            for (int e = 0; e < 8; ++e) v[e] = At[i * 68 + iperm(pq * 8 + e)];
            u32x4 pk; pk.x = pk2(v[0], v[1]); pk.y = pk2(v[2], v[3]); pk.z = pk2(v[4], v[5]); pk.w = pk2(v[6], v[7]);
            *(u32x4*)(abuf + (tok0 + i) * 256 + h * 64 + pq * 8) = pk;
        }
    }
    __syncthreads();
    for (int idx = tid; idx < 64 * 128; idx += 512) {
        const int i = idx >> 7, d = idx & 127;
        Ks[i * 132 + d] *= bt[i] * __expf(gb[i]);
        Vs[i * 132 + d] *= bt[i];
    }
    __syncthreads();
    if (tid < 256) {
        const int which = tid >> 7, d = tid & 127;
        float* rhs = (which == 0 ? Ks : Vs) + d;
        float s[64];
#pragma unroll
        for (int i = 0; i < 64; ++i) {
            float a = rhs[i * 132];
#pragma unroll
            for (int j4 = 0; j4 < (i + 3) / 4; ++j4) {
                const f32x4 av = *(const f32x4*)(Am + i * 68 + j4 * 4);
#pragma unroll
                for (int e = 0; e < 4; ++e) if (j4 * 4 + e < i) a -= av[e] * s[j4 * 4 + e];
            }
            s[i] = a;
        }
        if (which == 0) {
#pragma unroll
            for (int i = 0; i < 64; ++i) rhs[i * 132] = s[i];
        } else {
            bf16_t* up = proj + (tok0 + (d >> 1)) * PC + OV + h * 128 + (d & 1) * 64;
#pragma unroll
            for (int q = 0; q < 8; ++q) { u32x4 pk; pk.x = pk2(s[q * 8], s[q * 8 + 1]); pk.y = pk2(s[q * 8 + 2], s[q * 8 + 3]); pk.z = pk2(s[q * 8 + 4], s[q * 8 + 5]); pk.w = pk2(s[q * 8 + 6], s[q * 8 + 7]); *(u32x4*)(up + q * 8) = pk; }
        }
    }
    __syncthreads();
#pragma unroll
    for (int q = 0; q < 2; ++q) {
        const int idx = tid + 512 * q, i = idx >> 4, pq = idx & 15;
        float v[8];
#pragma unroll
        for (int e = 0; e < 8; ++e) v[e] = Ks[i * 132 + iperm(pq * 8 + e)];
        u32x4 pk; pk.x = pk2(v[0], v[1]); pk.y = pk2(v[2], v[3]); pk.z = pk2(v[4], v[5]); pk.w = pk2(v[6], v[7]);
        *(u32x4*)(wbuf + (tok0 + i) * 512 + h * 128 + pq * 8) = pk;
    }
    __syncthreads();
}

__device__ __forceinline__ void ssd_prep(const Params& p, int l, int b, int n, float* sm) {
    bf16_t* proj = (bf16_t*)(p.ws + WS_PROJ); const bf16_t* halo = (const bf16_t*)(p.ws + WS_HALO);
    bf16_t* cbbuf = (bf16_t*)(p.ws + WS_M + 50331648);
    float* dtb = (float*)(p.ws + WS_DT); float* csb = (float*)(p.ws + WS_CS);
    const int tid = otid();
    const size_t tok0 = (size_t)b * SEQ + n * 64;
    const float* cw = p.in[8] + (size_t)l * 4 * CONVC; const float* cbv = p.in[9] + (size_t)l * CONVC;
    bf16_t* Lt = (bf16_t*)sm;
    float* la = sm + 26000;
    {
        const int nm1 = n > 0 ? n - 1 : 0;
        u32x4 sv[13];
#pragma unroll
        for (int q = 0; q < 13; ++q) {
            int idx = tid + 512 * q; idx = idx < 6432 ? idx : 6431;
            const int row = idx / 96, pc = idx % 96, r = row - 3, col = OXS + pc * 8;
            const bf16_t* ptr = (r >= 0) ? proj + (tok0 + r) * PC + col : halo + ((size_t)(b * 64 + nm1) * 3 + (r + 3)) * CONVC + col;
            sv[q] = *(const u32x4*)ptr;
        }
#pragma unroll
        for (int q = 0; q < 13; ++q) {
            const int idx = tid + 512 * q;
            if (idx < 6432) {
                const int row = idx / 96, pc = idx % 96, r = row - 3;
                u32x4 v = sv[q];
                if (r < 0 && n == 0) v = (u32x4){0u, 0u, 0u, 0u};
                *(u32x4*)(Lt + row * 776 + pc * 8) = v;
            }
        }
    }
    __syncthreads();
    for (int c = tid; c < 768; c += 512) {
        const int col = OXS + c;
        const float w0 = cw[col], w1 = cw[CONVC + col], w2 = cw[2 * CONVC + col], w3 = cw[3 * CONVC + col], bb = cbv[col];
        float x0 = bf2f(Lt[c]), x1 = bf2f(Lt[776 + c]), x2 = bf2f(Lt[2 * 776 + c]);
#pragma unroll 8
        for (int r = 0; r < 64; ++r) {
            const float x3 = bf2f(Lt[(r + 3) * 776 + c]);
            Lt[r * 776 + c] = f2bf(siluf_(bb + w0 * x0 + w1 * x1 + w2 * x2 + w3 * x3));
            x0 = x1; x1 = x2; x2 = x3;
        }
    }
    {
        const int r = tid >> 3, j = tid & 7;
        const float dt = softplusf_(bf2f(proj[(tok0 + r) * PC + ODT + j]) + p.in[24][l * 8 + j]);
        dtb[(tok0 + r) * 8 + j] = dt;
        la[r * 8 + j] = -__expf(p.in[23][l * 8 + j]) * dt;
    }
    __syncthreads();
    { const int wv = __builtin_amdgcn_readfirstlane(tid >> 6), ln = tid & 63; csb[(tok0 + ln) * 8 + wv] = wave_incl_scan(la[ln * 8 + wv], ln); }
    {
        bf16_t* dst = proj + (tok0 + (tid & 63)) * PC + OXS + (tid >> 6) * 64;
#pragma unroll
        for (int q = 0; q < 8; ++q) {
            u32x4 pk;
            pk.x = (unsigned)Lt[(q * 8 + 0) * 776 + tid] | ((unsigned)Lt[(q * 8 + 1) * 776 + tid] << 16); pk.y = (unsigned)Lt[(q * 8 + 2) * 776 + tid] | ((unsigned)Lt[(q * 8 + 3) * 776 + tid] << 16);
            pk.z = (unsigned)Lt[(q * 8 + 4) * 776 + tid] | ((unsigned)Lt[(q * 8 + 5) * 776 + tid] << 16); pk.w = (unsigned)Lt[(q * 8 + 6) * 776 + tid] | ((unsigned)Lt[(q * 8 + 7) * 776 + tid] << 16);
            *(u32x4*)(dst + q * 8) = pk;
        }
    }
    if (tid < 128) {
        bf16_t* dst = proj + (tok0 + (tid & 63)) * PC + OBS + (tid >> 6) * 64;
        const int c = 512 + tid;
#pragma unroll
        for (int q = 0; q < 8; ++q) {
            u32x4 pk;
            pk.x = (unsigned)Lt[(q * 8 + 0) * 776 + c] | ((unsigned)Lt[(q * 8 + 1) * 776 + c] << 16); pk.y = (unsigned)Lt[(q * 8 + 2) * 776 + c] | ((unsigned)Lt[(q * 8 + 3) * 776 + c] << 16);
            pk.z = (unsigned)Lt[(q * 8 + 4) * 776 + c] | ((unsigned)Lt[(q * 8 + 5) * 776 + c] << 16); pk.w = (unsigned)Lt[(q * 8 + 6) * 776 + c] | ((unsigned)Lt[(q * 8 + 7) * 776 + c] << 16);
            *(u32x4*)(dst + q * 8) = pk;
        }
    } else if (tid < 256) {
        const int lrow = tid & 63, g = (tid >> 6) & 1;
        bf16_t* dst = proj + (tok0 + lrow) * PC + OCS + g * 64;
        const bf16_t* src = Lt + lrow * 776 + 640 + g * 64;
#pragma unroll
        for (int q = 0; q < 8; ++q) {
            u32x4 pk;
            pk.x = (unsigned)src[iperm(q * 8 + 0)] | ((unsigned)src[iperm(q * 8 + 1)] << 16); pk.y = (unsigned)src[iperm(q * 8 + 2)] | ((unsigned)src[iperm(q * 8 + 3)] << 16);
            pk.z = (unsigned)src[iperm(q * 8 + 4)] | ((unsigned)src[iperm(q * 8 + 5)] << 16); pk.w = (unsigned)src[iperm(q * 8 + 6)] | ((unsigned)src[iperm(q * 8 + 7)] << 16);
            *(u32x4*)(dst + q * 8) = pk;
        }
    }
    {
        const int lrow = tid >> 3, mg = tid & 7;
#pragma unroll 1
        for (int g = 0; g < 2; ++g) {
            float cb[8];
#pragma unroll
            for (int mm = 0; mm < 8; ++mm) cb[mm] = 0.f;
            const bf16_t* cp = Lt + lrow * 776 + 640 + g * 64;
#pragma unroll 4
            for (int q = 0; q < 64; q += 2) {
                const unsigned cu = *(const unsigned*)(cp + q);
                const float c0 = __uint_as_float(cu << 16), c1 = __uint_as_float(cu & 0xffff0000u);
#pragma unroll
                for (int mm = 0; mm < 8; ++mm) { const unsigned bu = *(const unsigned*)(Lt + (mg + 8 * mm) * 776 + 512 + g * 64 + q); cb[mm] += c0 * __uint_as_float(bu << 16) + c1 * __uint_as_float(bu & 0xffff0000u); }
            }
#pragma unroll
            for (int mm = 0; mm < 8; ++mm) cbbuf[(tok0 + lrow) * 128 + g * 64 + mg + 8 * mm] = f2bf(cb[mm]);
        }
    }
    __syncthreads();
}

template <int MODE>
__device__ __forceinline__ void lru_chunk(const Params& p, int l, int b, int n, float* sm) {
    bf16_t* proj = (bf16_t*)(p.ws + WS_PROJ); const bf16_t* halo = (const bf16_t*)(p.ws + WS_HALO);
    float* LA = (float*)(p.ws + WS_LA); float* LH = (float*)(p.ws + WS_LH);
    const bf16_t* Wt = (const bf16_t*)(p.ws + WS_PAR + 294912);
    const int tid = otid(), wid = __builtin_amdgcn_readfirstlane(tid >> 6), lane = tid & 63, fr = lane & 15, kg = lane >> 4;
    const int nb = wid, ch = nb * 64 + lane, col = OXL + ch;
    unsigned char* wbase = (unsigned char*)sm + wid * 18432;
    bf16_t* xb = (bf16_t*)wbase;
    float* pre = (float*)(wbase + 9728);
    const size_t tok0 = (size_t)b * SEQ + n * 64;
    const float* cw = p.in[8] + (size_t)l * 4 * CONVC; const float* cbv = p.in[9] + (size_t)l * CONVC;
    {
        const int nm1 = n > 0 ? n - 1 : 0;
        u32x4 sv[9];
#pragma unroll
        for (int q = 0; q < 9; ++q) {
            int idx = lane + 64 * q; idx = idx < 536 ? idx : 535;
            const int row = idx >> 3, pc = idx & 7, r = row - 3, c8 = OXL + nb * 64 + pc * 8;
            const bf16_t* ptr = (r >= 0) ? proj + (tok0 + r) * PC + c8 : halo + ((size_t)(b * 64 + nm1) * 3 + (r + 3)) * CONVC + c8;
            sv[q] = *(const u32x4*)ptr;
        }
#pragma unroll
        for (int q = 0; q < 9; ++q) {
            const int idx = lane + 64 * q;
            if (idx < 536) {
                const int row = idx >> 3, pc = idx & 7, r = row - 3;
                u32x4 v = sv[q];
                if (r < 0 && n == 0) v = (u32x4){0u, 0u, 0u, 0u};
                *(u32x4*)(xb + row * 72 + pc * 8) = v;
            }
        }
    }
    bf16x8 Wf[2][4][2];
#pragma unroll
    for (int gs = 0; gs < 2; ++gs)
#pragma unroll
        for (int et = 0; et < 4; ++et)
#pragma unroll
            for (int ks = 0; ks < 2; ++ks) Wf[gs][et][ks] = *(const bf16x8*)(Wt + ((size_t)((gs * 8 + nb) * 64 + 16 * et + fr)) * 64 + 32 * ks + 8 * kg);
    asm volatile("s_waitcnt lgkmcnt(0)" ::: "memory");
    {
        const float w0 = cw[col], w1 = cw[CONVC + col], w2 = cw[2 * CONVC + col], w3 = cw[3 * CONVC + col], bb = cbv[col];
        float x0 = bf2f(xb[lane]), x1 = bf2f(xb[72 + lane]), x2 = bf2f(xb[144 + lane]);
#pragma unroll 8
        for (int r = 0; r < 64; ++r) {
            const float x3 = bf2f(xb[(r + 3) * 72 + lane]);
            xb[r * 72 + lane] = f2bf(bb + w0 * x0 + w1 * x1 + w2 * x2 + w3 * x3);
            x0 = x1; x1 = x2; x2 = x3;
        }
    }
    asm volatile("s_waitcnt lgkmcnt(0)" ::: "memory");
    const float sp = 8.0f * softplusf_(-p.in[27][l * 512 + ch]);
    const float br_ = p.in[29][l * 512 + ch], bi_ = p.in[31][l * 512 + ch];
    const size_t ci = ((size_t)b * 64 + n) * 512 + ch;
    float H = (MODE == 1) ? LH[ci] : 0.f, A = 1.f;
#pragma unroll 1
    for (int q = 0; q < 4; ++q) {
        bf16_t gq[16];
        if (MODE == 1) {
#pragma unroll
            for (int t = 0; t < 16; ++t) gq[t] = proj[(tok0 + 16 * q + t) * PC + OGL + ch];
        }
        bf16x8 af[2];
#pragma unroll
        for (int ks = 0; ks < 2; ++ks) af[ks] = *(const bf16x8*)(xb + (16 * q + fr) * 72 + 32 * ks + 8 * kg);
#pragma unroll
        for (int gs = 0; gs < 2; ++gs)
#pragma unroll
            for (int et = 0; et < 4; ++et) {
                f32x4 acc = (f32x4){0.f, 0.f, 0.f, 0.f};
                acc = __builtin_amdgcn_mfma_f32_16x16x32_bf16(af[0], Wf[gs][et][0], acc, 0, 0, 0);
                acc = __builtin_amdgcn_mfma_f32_16x16x32_bf16(af[1], Wf[gs][et][1], acc, 0, 0, 0);
#pragma unroll
                for (int r = 0; r < 4; ++r) pre[(4 * kg + r) * 132 + gs * 64 + 16 * et + fr] = acc[r];
            }
        asm volatile("s_waitcnt lgkmcnt(0)" ::: "memory");
#pragma unroll
        for (int t = 0; t < 16; ++t) {
            const int r = 16 * q + t;
            const float rg = sigmoidf_(pre[t * 132 + lane] + br_), ig = sigmoidf_(pre[t * 132 + 64 + lane] + bi_);
            const float log_a = -sp * rg;
            const float a = __expf(log_a);
            float mult = __builtin_amdgcn_sqrtf(fmaxf(1.0f - a * a, 0.f));
            if (n == 0 && r == 0) mult = 1.0f;
            H = a * H + mult * ig * bf2f(xb[r * 72 + lane]);
            if (MODE == 0) A *= a;
            else {
                const float gt = bf2f(gq[t]);
                proj[(tok0 + r) * PC + col] = f2bf(H * geluf_(gt));
            }
        }
        asm volatile("s_waitcnt lgkmcnt(0)" ::: "memory");
    }
    if (MODE == 0) { LA[ci] = A; LH[ci] = H; }
    __syncthreads();
}

__device__ __forceinline__ void s5_consts(const Params& p, int l, int g, int pp, float& lr, float& li, float (&Br)[16], float (&Bi)[16]) {
    const int gp = (l * 24 + g) * 64 + pp;
    const float re = p.in[10][gp], im = p.in[11][gp], dt = __expf(p.in[12][l * 24 + g]);
    const float a = re * dt, th = im * dt;
    const float ea = __expf(a), cs = cosf(th), sn = sinf(th);
    lr = ea * cs; li = ea * sn;
    const float sh = sinf(0.5f * th);
    const float mr = expm1f(a) * cs - 2.0f * sh * sh, mi = li;
    const float den = 1.0f / (re * re + im * im);
    const float fr_ = (mr * re + mi * im) * den, fi_ = (mi * re - mr * im) * den;
#pragma unroll
    for (int h = 0; h < 16; ++h) {
        const float br = p.in[13][(size_t)gp * 16 + h], bi = p.in[14][(size_t)gp * 16 + h];
        Br[h] = fr_ * br - fi_ * bi; Bi[h] = fr_ * bi + fi_ * br;
    }
}
template <int MODE>
__device__ __forceinline__ void s5_chunk(const Params& p, int l, int b, int n, float* sm) {
    bf16_t* proj = (bf16_t*)(p.ws + WS_PROJ);
    float* S5C = (float*)(p.ws + WS_S5C);
    const bf16_t* gluT = (const bf16_t*)(p.ws + WS_PAR);
    float* us = sm;
    const int tid = otid(), wid = __builtin_amdgcn_readfirstlane(tid >> 6), lane = tid & 63, fr = lane & 15, kg = lane >> 4;
    bf16_t* xw = (bf16_t*)(sm + 24832) + wid * 2048;
    const size_t tok0 = (size_t)b * SEQ + n * 64;
#pragma unroll
    for (int q = 0; q < 6; ++q) {
        const int idx = tid + 512 * q, r = idx / 48, pc = idx % 48;
        const u32x4 v = *(const u32x4*)(proj + (tok0 + r) * PC + OU5 + pc * 8);
        *(f32x4*)(us + r * 388 + pc * 8) = up4((u32x2){v.x, v.y}); *(f32x4*)(us + r * 388 + pc * 8 + 4) = up4((u32x2){v.z, v.w});
    }
    __syncthreads();
    for (int g = wid; g < 24; g += 8) {
        float lr, li, Br[16], Bi[16];
        s5_consts(p, l, g, lane, lr, li, Br, Bi);
        f32x2 B2[16];
#pragma unroll
        for (int h = 0; h < 16; ++h) { B2[h].x = Br[h]; B2[h].y = Bi[h]; }
        float Xr = 0.f, Xi = 0.f;
        const size_t cidx = ((((size_t)b * 64 + n) * 24 + g) * 64 + lane) * 2;
        bf16x8 Cf[4];
        if (MODE == 1) {
            Xr = S5C[cidx]; Xi = S5C[cidx + 1];
            const float* crp = p.in[15] + ((size_t)(l * 24 + g) * 16 + fr) * 64; const float* cip = p.in[16] + ((size_t)(l * 24 + g) * 16 + fr) * 64;
#pragma unroll
            for (int ks = 0; ks < 4; ++ks) {
                const f32x4 cr = *(const f32x4*)(crp + 16 * ks + 4 * kg), ci = *(const f32x4*)(cip + 16 * ks + 4 * kg);
                Cf[ks] = pack8((f32x4){cr[0], -ci[0], cr[1], -ci[1]}, (f32x4){cr[2], -ci[2], cr[3], -ci[3]});
            }
        }
#pragma unroll 1
        for (int sb = 0; sb < 4; ++sb) {
#pragma unroll 4
            for (int ss = 0; ss < 16; ++ss) {
                const int s = sb * 16 + ss;
                f32x2 bu = {0.f, 0.f};
#pragma unroll
                for (int h4 = 0; h4 < 4; ++h4) {
                    const f32x4 u = *(const f32x4*)(us + s * 388 + g * 16 + h4 * 4);
                    bu += B2[h4 * 4 + 0] * u[0]; bu += B2[h4 * 4 + 1] * u[1]; bu += B2[h4 * 4 + 2] * u[2]; bu += B2[h4 * 4 + 3] * u[3];
                }
                const float nr = lr * Xr - li * Xi + bu.x, ni = lr * Xi + li * Xr + bu.y;
                Xr = nr; Xi = ni;
                if (MODE == 1) *(unsigned*)(xw + ss * 128 + 2 * lane) = pk2(Xr, Xi);
            }
            if (MODE == 1) {
                asm volatile("s_waitcnt lgkmcnt(0)" ::: "memory");
                f32x4 acc = (f32x4){0.f, 0.f, 0.f, 0.f};
                bf16x8 af[4];
#pragma unroll
                for (int ks = 0; ks < 4; ++ks) af[ks] = *(const bf16x8*)(xw + fr * 128 + 32 * ks + 8 * kg);
                asm volatile("s_waitcnt lgkmcnt(0)" ::: "memory");
#pragma unroll
                for (int ks = 0; ks < 4; ++ks) acc = __builtin_amdgcn_mfma_f32_16x16x32_bf16(af[ks], Cf[ks], acc, 0, 0, 0);
                const int c = g * 16 + fr; const float dd = p.in[17][l * 384 + c];
#pragma unroll
                for (int r = 0; r < 4; ++r) { const int s = sb * 16 + 4 * kg + r; us[s * 388 + c] = geluf_(acc[r] + dd * us[s * 388 + c]); }
            }
        }
        if (MODE == 0) { S5C[cidx] = Xr; S5C[cidx + 1] = Xi; }
    }
    __syncthreads();
    if (MODE == 1) {
        f32x4 acc[3][4];
#pragma unroll
        for (int a = 0; a < 3; ++a)
#pragma unroll
            for (int m = 0; m < 4; ++m) acc[a][m] = (f32x4){0.f, 0.f, 0.f, 0.f};
#pragma unroll 1
        for (int ks = 0; ks < 12; ++ks) {
            bf16x8 af[4];
#pragma unroll
            for (int m = 0; m < 4; ++m) { const float* ap = us + (16 * m + fr) * 388 + 32 * ks + 8 * kg; af[m] = pack8(*(const f32x4*)ap, *(const f32x4*)(ap + 4)); }
#pragma unroll
            for (int a = 0; a < 3; ++a) {
                const bf16x8 bfr = *(const bf16x8*)(gluT + (size_t)(16 * (wid * 3 + a) + fr) * 384 + 32 * ks + 8 * kg);
#pragma unroll
                for (int m = 0; m < 4; ++m) acc[a][m] = __builtin_amdgcn_mfma_f32_16x16x32_bf16(af[m], bfr, acc[a][m], 0, 0, 0);
            }
        }
        __syncthreads();
#pragma unroll
        for (int a = 0; a < 3; ++a) {
            const int j = 16 * (wid * 3 + a) + fr; const float gbias = p.in[19][l * 384 + j];
#pragma unroll
            for (int m = 0; m < 4; ++m)
#pragma unroll
                for (int r = 0; r < 4; ++r) { const int s = 16 * m + 4 * kg + r; us[s * 388 + j] *= sigmoidf_(acc[a][m][r] + gbias); }
        }
        __syncthreads();
#pragma unroll
        for (int q = 0; q < 6; ++q) {
            const int idx = tid + 512 * q, r = idx / 48, pc = idx % 48;
            const f32x4 a = *(const f32x4*)(us + r * 388 + pc * 8), c = *(const f32x4*)(us + r * 388 + pc * 8 + 4);
            u32x4 pk; pk.x = pk2(a[0], a[1]); pk.y = pk2(a[2], a[3]); pk.z = pk2(c[0], c[1]); pk.w = pk2(c[2], c[3]);
            *(u32x4*)(proj + (tok0 + r) * PC + OU5 + pc * 8) = pk;
        }
        __syncthreads();
    }
}

#define MFMA16(a, b, c) __builtin_amdgcn_mfma_f32_16x16x32_bf16((a), (b), (c), 0, 0, 0)
__device__ __forceinline__ void gdn_seq(const Params& p, int b, int h, int half, float* sm) {
    bf16_t* proj = (bf16_t*)(p.ws + WS_PROJ);
    const bf16_t* wbuf = (const bf16_t*)(p.ws + WS_M); const bf16_t* abuf = (const bf16_t*)(p.ws + WS_M + 33554432);
    const float* Gc = (const float*)(p.ws + WS_GC);
    unsigned char* L = (unsigned char*)sm;
    constexpr int OW = 0, OQL = 17408, OA = 34816, OKT = 44032, BUF = 62464;
    const int tid = otid(), wid = __builtin_amdgcn_readfirstlane(tid >> 6), lane = tid & 63, fr = lane & 15, kg = lane >> 4;
    const int e = (half * 4 + (wid & 3)) * 16 + fr;
    const bool cw_ = wid < 4;
    const size_t tokb = (size_t)b * SEQ;
    const int r16 = tid >> 4, pc16 = tid & 15, r8 = tid >> 3, pc8 = tid & 7;
    u32x4 gW[2], gQ[2], gA, gK[2]; u32x2 gU[4];
    auto issue = [&](int n) {
        const size_t tok0 = tokb + (size_t)n * 64;
#pragma unroll
        for (int q = 0; q < 2; ++q) {
            const int row = r16 + 32 * q;
            gW[q] = *(const u32x4*)(wbuf + (tok0 + row) * 512 + h * 128 + pc16 * 8);
            gQ[q] = *(const u32x4*)(proj + (tok0 + row) * PC + OQ + h * 128 + pc16 * 8);
            gK[q] = *(const u32x4*)(proj + (tok0 + row) * PC + OKK + h * 128 + pc16 * 8);
        }
        gA = *(const u32x4*)(abuf + (tok0 + r8) * 256 + h * 64 + pc8 * 8);
#pragma unroll
        for (int ct = 0; ct < 4; ++ct) gU[ct] = *(const u32x2*)(proj + (tok0 + (e >> 1)) * PC + OV + h * 128 + (e & 1) * 64 + 16 * ct + 4 * kg);
    };
    auto commit = [&](int buf) {
        unsigned char* B = L + buf * BUF;
#pragma unroll
        for (int q = 0; q < 2; ++q) {
            const int row = r16 + 32 * q;
            *(u32x4*)(B + OW + row * 272 + pc16 * 16) = gW[q];
            *(u32x4*)(B + OQL + row * 272 + pc16 * 16) = gQ[q];
            *(u32x4*)(B + OKT + (2 * row + (pc16 >> 3)) * 144 + (pc16 & 7) * 16) = gK[q];
        }
        *(u32x4*)(B + OA + r8 * 144 + pc8 * 16) = gA;
    };
    f32x4 S[8];
#pragma unroll
    for (int i = 0; i < 8; ++i) S[i] = (f32x4){0.f, 0.f, 0.f, 0.f};
    issue(0); commit(0);
    f32x4 U[4];
#pragma unroll
    for (int ct = 0; ct < 4; ++ct) U[ct] = up4(gU[ct]);
    __syncthreads();
#pragma unroll 1
    for (int n = 0; n < 64; ++n) {
        const unsigned char* B = L + (n & 1) * BUF;
        const size_t tok0 = tokb + (size_t)n * 64;
        if (n + 1 < 64) issue(n + 1);
        if (cw_) {
        const float gl = __expf(Gc[(tok0 + 63) * 4 + h]);
        bf16x8 Sf[4];
#pragma unroll
        for (int s4 = 0; s4 < 4; ++s4) Sf[s4] = pack8(S[2 * s4], S[2 * s4 + 1]);
        f32x4 V[4], O[4];
#pragma unroll
        for (int ct = 0; ct < 4; ++ct) {
            f32x4 t = (f32x4){0.f, 0.f, 0.f, 0.f}, o = (f32x4){0.f, 0.f, 0.f, 0.f};
#pragma unroll
            for (int s4 = 0; s4 < 4; ++s4) {
                const bf16x8 wf = *(const bf16x8*)(B + OW + (16 * ct + fr) * 272 + (32 * s4 + 8 * kg) * 2);
                const bf16x8 qf = *(const bf16x8*)(B + OQL + (16 * ct + fr) * 272 + (32 * s4 + 8 * kg) * 2);
                t = MFMA16(wf, Sf[s4], t); o = MFMA16(qf, Sf[s4], o);
            }
            V[ct] = U[ct] - t; O[ct] = o;
        }
        bf16x8 Vf[2];
        Vf[0] = pack8(V[0], V[1]); Vf[1] = pack8(V[2], V[3]);
#pragma unroll
        for (int ct = 0; ct < 4; ++ct) {
#pragma unroll
            for (int s2 = 0; s2 < 2; ++s2) {
                const bf16x8 af = *(const bf16x8*)(B + OA + (16 * ct + fr) * 144 + (32 * s2 + 8 * kg) * 2);
                O[ct] = MFMA16(af, Vf[s2], O[ct]);
            }
            u32x2 pk; pk.x = pk2(O[ct][0], O[ct][1]); pk.y = pk2(O[ct][2], O[ct][3]);
            *(u32x2*)(proj + (tok0 + (e >> 1)) * PC + OV + h * 128 + (e & 1) * 64 + 16 * ct + 4 * kg) = pk;
        }
#pragma unroll
        for (int dt = 0; dt < 8; ++dt) {
            f32x4 a = S[dt] * gl;
#pragma unroll
            for (int s2 = 0; s2 < 2; ++s2) {
                const bf16x8 kf = *(const bf16x8*)(B + OKT + (16 * dt + fr) * 144 + (32 * s2 + 8 * kg) * 2);
                a = MFMA16(kf, Vf[s2], a);
            }
            S[dt] = a;
        }
        }
        if (n + 1 < 64) {
            commit((n + 1) & 1);
#pragma unroll
            for (int ct = 0; ct < 4; ++ct) U[ct] = up4(gU[ct]);
        }
        __syncthreads();
    }
}

__device__ __forceinline__ void ssd_seq(const Params& p, int l, int b, int j, float* sm) {
    bf16_t* proj = (bf16_t*)(p.ws + WS_PROJ);
    const bf16_t* cbbuf = (const bf16_t*)(p.ws + WS_M + 50331648);
    const float* dtb = (const float*)(p.ws + WS_DT); const float* csb = (const float*)(p.ws + WS_CS);
    unsigned char* L = (unsigned char*)sm;
    constexpr int OCB = 0, OC = 9216, OBT = 18432, ODTL = 27648, OCSL = 27904, BUF = 28160;
    const int tid = otid(), wid = __builtin_amdgcn_readfirstlane(tid >> 6), lane = tid & 63, fr = lane & 15, kg = lane >> 4, g = j >> 2;
    const float dsk = p.in[25][l * 8 + j];
    const size_t tokb = (size_t)b * SEQ;
    const int r8 = tid >> 3, pc8 = tid & 7;
    const int pch = (wid & 3) * 16 + fr;
    u32x4 gCB, gC, gBT, gX[2]; u32x2 gXs[4]; float gv = 0.f;
    auto issue = [&](int n) {
        const size_t tok0 = tokb + (size_t)n * 64;
        gCB = *(const u32x4*)(cbbuf + (tok0 + r8) * 128 + g * 64 + pc8 * 8);
        gC = *(const u32x4*)(proj + (tok0 + r8) * PC + OCS + g * 64 + pc8 * 8);
        gBT = *(const u32x4*)(proj + (tok0 + r8) * PC + OBS + g * 64 + pc8 * 8);
        if (tid < 64) gv = dtb[(tok0 + tid) * 8 + j]; else if (tid < 128) gv = csb[(tok0 + tid - 64) * 8 + j];
        if (wid < 4) {
            const bf16_t* xp = proj + (tok0 + pch) * PC + OXS + j * 64;
#pragma unroll
            for (int s2 = 0; s2 < 2; ++s2) gX[s2] = *(const u32x4*)(xp + 32 * s2 + 8 * kg);
#pragma unroll
            for (int lt = 0; lt < 4; ++lt) gXs[lt] = *(const u32x2*)(xp + 16 * lt + 4 * kg);
        }
    };
    auto commit = [&](int buf) {
        unsigned char* B = L + buf * BUF;
        *(u32x4*)(B + OCB + r8 * 144 + pc8 * 16) = gCB;
        *(u32x4*)(B + OC + r8 * 144 + pc8 * 16) = gC;
        *(u32x4*)(B + OBT + r8 * 144 + pc8 * 16) = gBT;
        if (tid < 64) *(float*)(B + ODTL + tid * 4) = gv; else if (tid < 128) *(float*)(B + OCSL + (tid - 64) * 4) = gv;
    };
    f32x4 St[4];
#pragma unroll
    for (int i = 0; i < 4; ++i) St[i] = (f32x4){0.f, 0.f, 0.f, 0.f};
    issue(0); commit(0);
    u32x4 cX[2]; u32x2 cXs[4];
#pragma unroll
    for (int i = 0; i < 2; ++i) cX[i] = gX[i];
#pragma unroll
    for (int i = 0; i < 4; ++i) cXs[i] = gXs[i];
    __syncthreads();
#pragma unroll 1
    for (int n = 0; n < 64; ++n) {
        const unsigned char* B = L + (n & 1) * BUF;
        const size_t tok0 = tokb + (size_t)n * 64;
        if (n + 1 < 64) issue(n + 1);
        if (wid < 4) {
            const float* dtl = (const float*)(B + ODTL); const float* csl = (const float*)(B + OCSL);
            const float cend = csl[63];
            bf16x8 Xd[2], Xf[2];
#pragma unroll
            for (int s2 = 0; s2 < 2; ++s2) {
                const f32x4 xa = up4((u32x2){cX[s2].x, cX[s2].y}), xb = up4((u32x2){cX[s2].z, cX[s2].w});
                f32x4 da, db, fa, fb;
#pragma unroll
                for (int i = 0; i < 4; ++i) {
                    const int m0 = 32 * s2 + 8 * kg + i, m1 = m0 + 4;
                    da[i] = xa[i] * dtl[m0]; db[i] = xb[i] * dtl[m1];
                    fa[i] = da[i] * __expf(cend - csl[m0]); fb[i] = db[i] * __expf(cend - csl[m1]);
                }
                Xd[s2] = pack8(da, db); Xf[s2] = pack8(fa, fb);
            }
            bf16x8 Sb[2];
            Sb[0] = pack8(St[0], St[1]); Sb[1] = pack8(St[2], St[3]);
#pragma unroll
            for (int lt = 0; lt < 4; ++lt) {
                f32x4 y = (f32x4){0.f, 0.f, 0.f, 0.f};
#pragma unroll
                for (int s2 = 0; s2 < 2; ++s2) { const bf16x8 cf = *(const bf16x8*)(B + OC + (16 * lt + fr) * 144 + (32 * s2 + 8 * kg) * 2); y = MFMA16(cf, Sb[s2], y); }
#pragma unroll
                for (int r = 0; r < 4; ++r) y[r] *= __expf(csl[16 * lt + 4 * kg + r]);
                const int lrow = 16 * lt + fr; const float cl_ = csl[lrow];
#pragma unroll
                for (int s2 = 0; s2 < 2; ++s2) {
                    if (32 * s2 <= 16 * lt + 15) {
                        const u32x4 raw = *(const u32x4*)(B + OCB + lrow * 144 + (32 * s2 + 8 * kg) * 2);
                        const f32x4 ca = up4((u32x2){raw.x, raw.y}), cb = up4((u32x2){raw.z, raw.w});
                        f32x4 ea, eb;
#pragma unroll
                        for (int i = 0; i < 4; ++i) {
                            const int m0 = 32 * s2 + 8 * kg + i, m1 = m0 + 4;
                            ea[i] = (m0 <= lrow) ? ca[i] * __expf(cl_ - csl[m0]) : 0.f;
                            eb[i] = (m1 <= lrow) ? cb[i] * __expf(cl_ - csl[m1]) : 0.f;
                        }
                        y = MFMA16(pack8(ea, eb), Xd[s2], y);
                    }
                }
                const f32x4 xs = up4(cXs[lt]);
                y = y + xs * dsk;
                u32x2 pk; pk.x = pk2(y[0], y[1]); pk.y = pk2(y[2], y[3]);
                *(u32x2*)(proj + (tok0 + pch) * PC + OXS + j * 64 + 16 * lt + 4 * kg) = pk;
            }
            const float ee = __expf(cend);
#pragma unroll
            for (int nt = 0; nt < 4; ++nt) {
                f32x4 a = St[nt] * ee;
#pragma unroll
                for (int s2 = 0; s2 < 2; ++s2) { const bf16x8 bf = *(const bf16x8*)(B + OBT + (16 * nt + fr) * 144 + (32 * s2 + 8 * kg) * 2); a = MFMA16(bf, Xf[s2], a); }
                St[nt] = a;
            }
        }
        if (n + 1 < 64) {
            commit((n + 1) & 1);
#pragma unroll
            for (int i = 0; i < 2; ++i) cX[i] = gX[i];
#pragma unroll
            for (int i = 0; i < 4; ++i) cXs[i] = gXs[i];
        }
        __syncthreads();
    }
}

__device__ __forceinline__ void s5_carry(const Params& p, int l, int it) {
    float* S5C = (float*)(p.ws + WS_S5C);
    const int idx = it * 512 + otid();
    const int b = idx / 1536, gp = idx % 1536, g = gp >> 6;
    const float re = p.in[10][l * 1536 + gp], im = p.in[11][l * 1536 + gp], dt = __expf(p.in[12][l * 24 + g]);
    const float ea = __expf(64.0f * re * dt), th = 64.0f * im * dt;
    const float lr = ea * cosf(th), li = ea * sinf(th);
    float Xr = 0.f, Xi = 0.f;
    for (int n = 0; n < 64; ++n) {
        const size_t ci = (((size_t)b * 64 + n) * 1536 + gp) * 2;
        const float a = S5C[ci], c = S5C[ci + 1];
        S5C[ci] = Xr; S5C[ci + 1] = Xi;
        const float nr = lr * Xr - li * Xi + a, ni = lr * Xi + li * Xr + c;
        Xr = nr; Xi = ni;
    }
}
__device__ __forceinline__ void lru_carry(const Params& p, int it) {
    float* LA = (float*)(p.ws + WS_LA); float* LH = (float*)(p.ws + WS_LH);
    const int idx = it * 512 + otid();
    const int b = idx >> 9, ch = idx & 511;
    float H = 0.f;
    for (int n = 0; n < 64; ++n) {
        const size_t ci = ((size_t)b * 64 + n) * 512 + ch;
        const float a = LA[ci], hl = LH[ci];
        LH[ci] = H;
        H = a * H + hl;
    }
}

__device__ __forceinline__ void gdn_post(const Params& p, int l, int b, int n, float* sm) {
    bf16_t* proj = (bf16_t*)(p.ws + WS_PROJ);
    const int tid = otid(), wid = __builtin_amdgcn_readfirstlane(tid >> 6), lane = tid & 63;
    const size_t tok0 = (size_t)b * SEQ + n * 64;
    float* Tt = sm;
#pragma unroll 1
    for (int h = 0; h < 4; ++h) {
#pragma unroll
        for (int q = 0; q < 2; ++q) {
            const int idx = tid + 512 * q, grow = idx >> 4, pc = idx & 15, e = 2 * grow + (pc >> 3), c0 = (pc & 7) * 8;
            const u32x4 v = *(const u32x4*)(proj + (tok0 + grow) * PC + OV + h * 128 + pc * 8);
            const f32x4 a = up4((u32x2){v.x, v.y}), bq = up4((u32x2){v.z, v.w});
#pragma unroll
            for (int i = 0; i < 4; ++i) { Tt[e * 65 + c0 + i] = a[i]; Tt[e * 65 + c0 + 4 + i] = bq[i]; }
        }
        __syncthreads();
        const float nw0 = p.in[22][l * 128 + lane], nw1 = p.in[22][l * 128 + lane + 64];
        for (int c = wid * 8; c < wid * 8 + 8; ++c) {
            const float o0 = Tt[lane * 65 + c], o1 = Tt[(lane + 64) * 65 + c];
            const float ss = wave_sum(o0 * o0 + o1 * o1);
            const float rstd = rsqrtf(ss * (1.0f / 128.0f) + 1e-6f);
            bf16_t* op = proj + (tok0 + c) * PC + OV + h * 128;
            const bf16_t* zp = proj + (tok0 + c) * PC + OZG + h * 128;
            op[lane] = f2bf(o0 * rstd * nw0 * siluf_(bf2f(zp[lane])));
            op[lane + 64] = f2bf(o1 * rstd * nw1 * siluf_(bf2f(zp[lane + 64])));
        }
        __syncthreads();
    }
}
__device__ __forceinline__ void ssd_post(const Params& p, int l, int b, int n, float* sm) {
    bf16_t* proj = (bf16_t*)(p.ws + WS_PROJ);
    const int tid = otid(), wid = __builtin_amdgcn_readfirstlane(tid >> 6), lane = tid & 63;
    const size_t tok0 = (size_t)b * SEQ + n * 64;
    float* Y = sm;
#pragma unroll
    for (int q = 0; q < 8; ++q) {
        const int idx = tid + 512 * q, j = idx >> 9, prow = (idx >> 3) & 63, pc = idx & 7;
        const u32x4 v = *(const u32x4*)(proj + (tok0 + prow) * PC + OXS + j * 64 + pc * 8);
        const f32x4 a = up4((u32x2){v.x, v.y}), bq = up4((u32x2){v.z, v.w});
#pragma unroll
        for (int i = 0; i < 4; ++i) { Y[(pc * 8 + i) * 516 + j * 64 + prow] = a[i]; Y[(pc * 8 + 4 + i) * 516 + j * 64 + prow] = bq[i]; }
    }
    __syncthreads();
    for (int r = wid * 8; r < wid * 8 + 8; ++r) {
        bf16_t* yp = proj + (tok0 + r) * PC + OXS;
        const bf16_t* zp = proj + (tok0 + r) * PC + OZS;
        float v[8]; float ss = 0.f;
#pragma unroll
        for (int k = 0; k < 8; ++k) { const int c = lane + 64 * k; v[k] = Y[r * 516 + c] * siluf_(bf2f(zp[c])); ss += v[k] * v[k]; }
        ss = wave_sum(ss);
        const float rstd = rsqrtf(ss * (1.0f / 512.0f) + 1e-6f);
#pragma unroll
        for (int k = 0; k < 8; ++k) { const int c = lane + 64 * k; yp[c] = f2bf(v[k] * rstd * p.in[26][l * 512 + c]); }
    }
    __syncthreads();
}

#define OPQ(v) asm volatile("" : "+s"(v))
#define FRESHP const Params& p = *kparams(); float* mod = (float*)(p.ws + WS_MOD); bf16_t* proj = (bf16_t*)(p.ws + WS_PROJ); bf16_t* hbuf = (bf16_t*)(p.ws + WS_H); bf16_t* mbuf = (bf16_t*)(p.ws + WS_M); const float* modl = mod + (size_t)l * 8 * 6144; const float* xin = (l == 0) ? p.in[0] : p.out; (void)proj; (void)hbuf; (void)mbuf; (void)modl; (void)xin;
template <int LL> __device__ __forceinline__ void run_layer(float* sm, LAS unsigned char* lds) {
    int l = LL;
        { FRESHP convert_layer(p, l, sm); }
        if (l == 0) cg::this_grid().sync();
        OPQ(l);
        { FRESHP norm_phase(xin, p.in[2] + l * 1024, modl, 0, 1024, hbuf); }
        cg::this_grid().sync(); OPQ(l);
        { FRESHP ProgProj pg; pg.ord.init(128, 19, ogrid(), obid()); pg.A = (const char*)hbuf; pg.B = (const char*)(p.ws + WS_BTIN); pg.proj = proj; pg.halo = (bf16_t*)(p.ws + WS_HALO); gemm_run(lds, pg); }
        cg::this_grid().sync(); OPQ(l);
        { FRESHP for (int it = obid(), G = ogrid(); it < 2048 + 1536; it += G) {
            if (it < 2048) { const int tl = it >> 2, h = it & 3; gdn_prep(p, l, tl >> 6, tl & 63, h, sm); }
            else { const int r = it - 2048, part = r / 512, tl = r % 512; const int b = tl >> 6, n = tl & 63;
                if (part == 0) ssd_prep(p, l, b, n, sm); else if (part == 1) lru_chunk<0>(p, l, b, n, sm); else s5_chunk<0>(p, l, b, n, sm); }
        } }
        cg::this_grid().sync(); OPQ(l);
        { FRESHP for (int it = obid(), G = ogrid(); it < 64 + 64 + 24 + 8; it += G) {
            if (it < 64) gdn_seq(p, it >> 3, (it >> 1) & 3, it & 1, sm);
            else if (it < 128) { const int r = it - 64; ssd_seq(p, l, r >> 3, r & 7, sm); }
            else if (it < 152) s5_carry(p, l, it - 128);
            else lru_carry(p, it - 152);
            __syncthreads();
        } }
        cg::this_grid().sync(); OPQ(l);
        { FRESHP for (int it = obid(), G = ogrid(); it < 2048; it += G) {
            const int part = it / 512, tl = it % 512; const int b = tl >> 6, n = tl & 63;
            if (part == 0) s5_chunk<1>(p, l, b, n, sm); else if (part == 1) lru_chunk<1>(p, l, b, n, sm); else if (part == 2) gdn_post(p, l, b, n, sm); else ssd_post(p, l, b, n, sm);
        } }
        cg::this_grid().sync(); OPQ(l);
        { FRESHP ProgMerge pg; pg.ord.init(128, 4, ogrid(), obid()); pg.H = (const char*)hbuf; pg.Bg = (const char*)(p.ws + WS_BTIN) + (size_t)PC * 1024 * 2; pg.Bb = (const char*)(p.ws + WS_BTBR); pg.P = (const char*)proj; pg.proj = proj; pg.mb = mbuf; gemm_run(lds, pg); }
        cg::this_grid().sync(); OPQ(l);
        { FRESHP ProgRes pg; pg.ord.init(128, 4, ogrid(), obid()); pg.A = (const char*)mbuf; pg.B = (const char*)(p.ws + WS_BTOUT); pg.lda = 1024; pg.nt = 16; pg.xin = xin; pg.xout = p.out; pg.gt = modl + 2048; gemm_run(lds, pg); }
        cg::this_grid().sync(); OPQ(l);
        { FRESHP norm_phase(p.out, p.in[3] + l * 1024, modl, 3072, 4096, hbuf); }
        cg::this_grid().sync(); OPQ(l);
        { FRESHP ProgSwi pg; pg.ord.init(128, 22, ogrid(), obid()); pg.A = (const char*)hbuf; pg.B = (const char*)(p.ws + WS_BT13); pg.act = proj; gemm_run(lds, pg); }
        cg::this_grid().sync(); OPQ(l);
        { FRESHP ProgRes pg; pg.ord.init(128, 4, ogrid(), obid()); pg.A = (const char*)proj; pg.B = (const char*)(p.ws + WS_BT2); pg.lda = FH; pg.nt = 44; pg.xin = p.out; pg.xout = p.out; pg.gt = modl + 5120; gemm_run(lds, pg); }
        cg::this_grid().sync(); OPQ(l);
    }

__global__ void __launch_bounds__(512) trunk_fwd(Params p_unused) {
    extern __shared__ __attribute__((aligned(16))) unsigned char smem[];
    float* sm = (float*)smem;
    LAS unsigned char* lds = (LAS unsigned char*)smem;

    { const Params& p = *kparams(); mod_phase(p, sm); }
    run_layer<0>(sm, lds);
    run_layer<1>(sm, lds);
    { const Params& p = *kparams(); final_norm_phase(p.out, p.in[4]); }
}

extern "C" void kernel_launch(void* const* d_in, const int* in_sizes, int n_in, void* d_out, int out_size, void* d_ws, size_t ws_size, hipStream_t stream) {
    static int grid = 0;
    if (grid == 0) {
        if (n_in != 36 || ws_size < WS_END) { fprintf(stderr, "kernel_launch: need 36 inputs and >= %zu bytes of workspace; got %d, %zu\n", (size_t)WS_END, n_in, ws_size); grid = -1; return; }
        int dev = 0, cus = 0, per_cu = 0;
        (void)hipGetDevice(&dev);
        (void)hipDeviceGetAttribute(&cus, hipDeviceAttributeMultiprocessorCount, dev);
        if (hipFuncSetAttribute((const void*)trunk_fwd, hipFuncAttributeMaxDynamicSharedMemorySize, LDS_BYTES) != hipSuccess) { fprintf(stderr, "kernel_launch: hipFuncSetAttribute failed\n"); grid = -1; return; }
        if (hipOccupancyMaxActiveBlocksPerMultiprocessor(&per_cu, (const void*)trunk_fwd, 512, LDS_BYTES) != hipSuccess || per_cu < 1) { fprintf(stderr, "kernel_launch: occupancy query says %d\n", per_cu); per_cu = 1; }
        (void)hipGetLastError();
        grid = cus * 1;
    }
    if (grid < 0) return;
    Params p{};
    for (int i = 0; i < 36; ++i) p.in[i] = (const float*)d_in[i];
    p.out = (float*)d_out; p.ws = (unsigned char*)d_ws;
    void* args[] = {&p};
    hipError_t e = hipLaunchCooperativeKernel((const void*)trunk_fwd, dim3(grid), dim3(512), args, LDS_BYTES, stream);
    if (e != hipSuccess) fprintf(stderr, "cooperative launch failed: %s (grid %d)\n", hipGetErrorString(e), grid);
}
```
